# Optimizing an MI355X kernel written in HIP

```python
import math
import jax, jax.numpy as jnp
from jax import lax
import numpy as np

D_MODEL = 1024
BATCH = 2
SEQ = 8192
DEPTH = 1
DEC_BATCH = 128
DEC_SEQ = 1
PAST_LEN = 2048
PAGE_SIZE = 128

PLE_DIM = 256
LRU_WIDTH = 512
LRU_BLOCKS = 8
LRU_BLOCK = LRU_WIDTH // LRU_BLOCKS
CONV_WIDTH = 4
ATT_HEADS = 4
ATT_HD = 64
ATT_WIDTH = ATT_HEADS * 2 * ATT_HD
MIX_WIDTH = LRU_WIDTH + ATT_WIDTH
IN_WIDTH = 2 * LRU_WIDTH + 3 * ATT_WIDTH
SPLITS = (LRU_WIDTH, 2 * LRU_WIDTH, 2 * LRU_WIDTH + ATT_WIDTH, 2 * LRU_WIDTH + 2 * ATT_WIDTH)
ROT_DIM = ATT_HD // 4
ROPE_THETA = 500000.0
Q_BLOCK = 128
D_FF = -(-8 * D_MODEL // (3 * 256)) * 256
NEG_INF = -1e30

kernel_name = 'hymba_rglru_diffattn_decode_step'


def _rmsnorm(x, g, eps=1e-6):
    xf = x.astype(jnp.float32)
    y = xf * lax.rsqrt(jnp.mean(xf * xf, axis=-1, keepdims=True) + eps)
    return (y * g.astype(jnp.float32)).astype(x.dtype)


def _rope(t, pos):
    half = ROT_DIM // 2
    inv = ROPE_THETA ** (-jnp.arange(0, ROT_DIM, 2, dtype=jnp.float32) / ROT_DIM)
    ang = pos.astype(jnp.float32)[:, None] * inv[None, :]
    cos = jnp.cos(ang)[None, :, None, :]
    sin = jnp.sin(ang)[None, :, None, :]
    tf = t.astype(jnp.float32)
    t1 = tf[..., :half]
    t2 = tf[..., half:ROT_DIM]
    out = jnp.concatenate([t1 * cos - t2 * sin, t2 * cos + t1 * sin, tf[..., ROT_DIM:]], axis=-1)
    return out.astype(t.dtype)


def _lin_combine(c1, c2):
    a1, b1 = c1
    a2, b2 = c2
    return a1 * a2, a2 * b1 + b2


def _diff_attend(q1, q2, k1, k2, v, q_pos, k_pos, lam):
    scale = ATT_HD ** -0.5
    mask = k_pos[None, :] <= q_pos[:, None]

    def probs(q, k):
        s = jnp.einsum('bqhd,bkhd->bhqk', q.astype(jnp.float32), k.astype(jnp.float32)) * scale
        return jax.nn.softmax(jnp.where(mask, s, NEG_INF), axis=-1)

    w = probs(q1, k1) - lam * probs(q2, k2)
    return jnp.einsum('bhqk,bkhe->bqhe', w, v.astype(jnp.float32))


def _attend(q1, q2, k1, k2, v, q_pos, k_pos, lam):
    b, sq = q1.shape[0], q1.shape[1]
    if sq <= Q_BLOCK or sq % Q_BLOCK != 0:
        return _diff_attend(q1, q2, k1, k2, v, q_pos, k_pos, lam)
    nb = sq // Q_BLOCK

    def split(t):
        return jnp.moveaxis(t.reshape((b, nb, Q_BLOCK) + t.shape[2:]), 1, 0)

    def one(args):
        qa, qb, qp = args
        return _diff_attend(qa, qb, k1, k2, v, qp, k_pos, lam)

    out = lax.map(one, (split(q1), split(q2), q_pos.reshape(nb, Q_BLOCK)))
    return jnp.moveaxis(out, 0, 1).reshape((b, sq) + out.shape[3:])


def _layer(x, p, conv_prev, h_prev, k_past, v_past, lw, lam_init):
    b, s, _ = x.shape
    past = 0 if k_past is None else k_past.shape[1]
    q_pos = past + jnp.arange(s, dtype=jnp.int32)

    h = _rmsnorm(x, lw['norm_pre_mix'])
    u = h @ lw['w_in']
    xl, gl, q, k, v = jnp.split(u, SPLITS, axis=-1)

    xpad = jnp.concatenate([conv_prev.astype(xl.dtype), xl], axis=1)
    xc = lw['conv_b'] + xpad[:, 0:s] * lw['conv_w'][0]
    for j in range(1, CONV_WIDTH):
        xc = xc + xpad[:, j:j + s] * lw['conv_w'][j]
    new_conv = xpad[:, -(CONV_WIDTH - 1):]
    xb = xc.reshape(b, s, LRU_BLOCKS, LRU_BLOCK)
    r = jax.nn.sigmoid(jnp.einsum('bsni,nij->bsnj', xb, lw['lru_w_a']) + lw['lru_b_a']).reshape(b, s, LRU_WIDTH)
    ig = jax.nn.sigmoid(jnp.einsum('bsni,nij->bsnj', xb, lw['lru_w_x']) + lw['lru_b_x']).reshape(b, s, LRU_WIDTH)
    log_a = -8.0 * r.astype(jnp.float32) * jax.nn.softplus(-lw['lru_L'].astype(jnp.float32))
    a = jnp.exp(log_a)
    bt = jnp.sqrt(-jnp.expm1(2.0 * log_a)) * (ig * xc).astype(jnp.float32)
    bt = bt.at[:, 0].add(a[:, 0] * h_prev.astype(jnp.float32))
    _, hs = lax.associative_scan(_lin_combine, (a, bt), axis=1)
    lru_out = hs.astype(x.dtype) * jax.nn.gelu(gl)
    new_h = hs[:, -1].astype(x.dtype)

    q = q.reshape(b, s, ATT_HEADS, 2, ATT_HD)
    k = k.reshape(b, s, ATT_HEADS, 2, ATT_HD)
    q1 = _rope(q[..., 0, :], q_pos)
    q2 = _rope(q[..., 1, :], q_pos)
    k_new = jnp.concatenate([_rope(k[..., 0, :], q_pos), _rope(k[..., 1, :], q_pos)], axis=-1)
    v_new = v.reshape(b, s, ATT_HEADS, 2 * ATT_HD)
    if k_past is None:
        k_all, v_all, k_pos = k_new, v_new, q_pos
    else:
        k_all = jnp.concatenate([k_past.astype(k_new.dtype), k_new], axis=1)
        v_all = jnp.concatenate([v_past.astype(v_new.dtype), v_new], axis=1)
        k_pos = jnp.arange(past + s, dtype=jnp.int32)
    f32 = jnp.float32
    lam = (jnp.exp(jnp.sum(lw['lambda_q1'].astype(f32) * lw['lambda_k1'].astype(f32)))
           - jnp.exp(jnp.sum(lw['lambda_q2'].astype(f32) * lw['lambda_k2'].astype(f32))) + lam_init)
    o = _attend(q1, q2, k_all[..., :ATT_HD], k_all[..., ATT_HD:], v_all, q_pos, k_pos, lam)
    o = _rmsnorm(o, lw['subln_g'], eps=1e-5) * (1.0 - lam_init)
    att_out = o.reshape(b, s, ATT_WIDTH).astype(x.dtype)

    mix = jnp.concatenate([lru_out, att_out], axis=-1) @ lw['w_out']
    x = x + _rmsnorm(mix, lw['norm_post_mix'])

    h = _rmsnorm(x, lw['norm_pre_ffn'])
    f = (jax.nn.silu(h @ lw['ffn_w_gate']) * (h @ lw['ffn_w_up'])) @ lw['ffn_w_down']
    x = x + _rmsnorm(f, lw['norm_post_ffn'])

    gate = jax.nn.sigmoid(x @ lw['ple_w_gate'])
    x = x + _rmsnorm(gate * (p @ lw['ple_w_proj']), lw['ple_norm'])
    return x, k_new, v_new, new_conv, new_h


def setup_inputs(seed: int = 0) -> dict:
    key = jax.random.key(seed)
    ks = jax.random.split(key, 40)
    f32 = jnp.float32
    n_pages = PAST_LEN // PAGE_SIZE
    n_used = DEC_BATCH * n_pages
    n_phys = n_used + max(1, n_used // 4)

    def nrm(k, shape, scale):
        return jax.random.normal(k, shape, f32) * scale

    def gain(k, shape):
        return 1.0 + 0.05 * jax.random.normal(k, shape, f32)

    page_table = jax.random.permutation(ks[0], n_phys)[:n_used].reshape(DEC_BATCH, n_pages).astype(jnp.int32)
    a0 = jax.random.uniform(ks[1], (DEPTH, LRU_WIDTH), f32, 0.9, 0.999)
    lru_L = jnp.log(a0) - jnp.log1p(-a0)
    return {
        'x_prompt': nrm(ks[2], (BATCH, SEQ, D_MODEL), 1.0),
        'x_sample': nrm(ks[3], (DEC_BATCH, DEC_SEQ, D_MODEL), 1.0),
        'cache_k': nrm(ks[4], (DEPTH, n_phys, PAGE_SIZE, ATT_HEADS, 2 * ATT_HD), 1.0),
        'cache_v': nrm(ks[5], (DEPTH, n_phys, PAGE_SIZE, ATT_HEADS, 2 * ATT_HD), 1.0),
        'state_conv': nrm(ks[6], (DEPTH, DEC_BATCH, CONV_WIDTH - 1, LRU_WIDTH), 1.0),
        'state_h': nrm(ks[7], (DEPTH, DEC_BATCH, LRU_WIDTH), 0.5),
        'page_table': page_table,
        'p_prompt': nrm(ks[8], (DEPTH, BATCH, SEQ, PLE_DIM), 1.0),
        'p_sample': nrm(ks[9], (DEPTH, DEC_BATCH, DEC_SEQ, PLE_DIM), 1.0),
        'norm_pre_mix': gain(ks[10], (DEPTH, D_MODEL)),
        'w_in': nrm(ks[11], (DEPTH, D_MODEL, IN_WIDTH), D_MODEL ** -0.5),
        'conv_w': nrm(ks[12], (DEPTH, CONV_WIDTH, LRU_WIDTH), CONV_WIDTH ** -0.5),
        'conv_b': nrm(ks[13], (DEPTH, LRU_WIDTH), 0.02),
        'lru_w_a': nrm(ks[14], (DEPTH, LRU_BLOCKS, LRU_BLOCK, LRU_BLOCK), LRU_BLOCK ** -0.5),
        'lru_b_a': nrm(ks[15], (DEPTH, LRU_BLOCKS, LRU_BLOCK), 0.02),
        'lru_w_x': nrm(ks[16], (DEPTH, LRU_BLOCKS, LRU_BLOCK, LRU_BLOCK), LRU_BLOCK ** -0.5),
        'lru_b_x': nrm(ks[17], (DEPTH, LRU_BLOCKS, LRU_BLOCK), 0.02),
        'lru_L': lru_L,
        'lambda_q1': nrm(ks[18], (DEPTH, ATT_HD), 0.1),
        'lambda_k1': nrm(ks[19], (DEPTH, ATT_HD), 0.1),
        'lambda_q2': nrm(ks[20], (DEPTH, ATT_HD), 0.1),
        'lambda_k2': nrm(ks[21], (DEPTH, ATT_HD), 0.1),
        'subln_g': gain(ks[22], (DEPTH, 2 * ATT_HD)),
        'w_out': nrm(ks[23], (DEPTH, MIX_WIDTH, D_MODEL), MIX_WIDTH ** -0.5),
        'norm_post_mix': gain(ks[24], (DEPTH, D_MODEL)),
        'norm_pre_ffn': gain(ks[25], (DEPTH, D_MODEL)),
        'ffn_w_gate': nrm(ks[26], (DEPTH, D_MODEL, D_FF), D_MODEL ** -0.5),
        'ffn_w_up': nrm(ks[27], (DEPTH, D_MODEL, D_FF), D_MODEL ** -0.5),
        'ffn_w_down': nrm(ks[28], (DEPTH, D_FF, D_MODEL), D_FF ** -0.5),
        'norm_post_ffn': gain(ks[29], (DEPTH, D_MODEL)),
        'ple_w_gate': nrm(ks[30], (DEPTH, D_MODEL, D_MODEL), D_MODEL ** -0.5),
        'ple_w_proj': nrm(ks[31], (DEPTH, PLE_DIM, D_MODEL), PLE_DIM ** -0.5),
        'ple_norm': gain(ks[32], (DEPTH, D_MODEL)),
    }


def reference(x_prompt, x_sample, cache_k, cache_v, state_conv, state_h, page_table, p_prompt, p_sample,
              norm_pre_mix, w_in, conv_w, conv_b, lru_w_a, lru_b_a, lru_w_x, lru_b_x, lru_L,
              lambda_q1, lambda_k1, lambda_q2, lambda_k2, subln_g, w_out, norm_post_mix,
              norm_pre_ffn, ffn_w_gate, ffn_w_up, ffn_w_down, norm_post_ffn,
              ple_w_gate, ple_w_proj, ple_norm):
    n_pages = page_table.shape[1]
    xp, xs = x_prompt, x_sample
    kps, vps, cps, hps, kss, vss, css, hss = [], [], [], [], [], [], [], []
    for i in range(DEPTH):
        lw = {
            'norm_pre_mix': norm_pre_mix[i], 'w_in': w_in[i], 'conv_w': conv_w[i], 'conv_b': conv_b[i],
            'lru_w_a': lru_w_a[i], 'lru_b_a': lru_b_a[i], 'lru_w_x': lru_w_x[i], 'lru_b_x': lru_b_x[i],
            'lru_L': lru_L[i], 'lambda_q1': lambda_q1[i], 'lambda_k1': lambda_k1[i],
            'lambda_q2': lambda_q2[i], 'lambda_k2': lambda_k2[i], 'subln_g': subln_g[i],
            'w_out': w_out[i], 'norm_post_mix': norm_post_mix[i], 'norm_pre_ffn': norm_pre_ffn[i],
            'ffn_w_gate': ffn_w_gate[i], 'ffn_w_up': ffn_w_up[i], 'ffn_w_down': ffn_w_down[i],
            'norm_post_ffn': norm_post_ffn[i], 'ple_w_gate': ple_w_gate[i], 'ple_w_proj': ple_w_proj[i],
            'ple_norm': ple_norm[i],
        }
        lam_init = 0.8 - 0.6 * math.exp(-0.3 * i)
        conv0 = jnp.zeros((xp.shape[0], CONV_WIDTH - 1, LRU_WIDTH), xp.dtype)
        h0 = jnp.zeros((xp.shape[0], LRU_WIDTH), jnp.float32)
        xp, kp, vp, cp, hp = _layer(xp, p_prompt[i], conv0, h0, None, None, lw, lam_init)
        db = xs.shape[0]
        k_past = cache_k[i][page_table].reshape(db, n_pages * PAGE_SIZE, ATT_HEADS, 2 * ATT_HD)
        v_past = cache_v[i][page_table].reshape(db, n_pages * PAGE_SIZE, ATT_HEADS, 2 * ATT_HD)
        xs, ksm, vsm, csm, hsm = _layer(xs, p_sample[i], state_conv[i], state_h[i], k_past, v_past, lw, lam_init)
        kps.append(kp); vps.append(vp); cps.append(cp); hps.append(hp)
        kss.append(ksm); vss.append(vsm); css.append(csm); hss.append(hsm)
    return (xp, xs, jnp.stack(kps), jnp.stack(vps), jnp.stack(cps), jnp.stack(hps),
            jnp.stack(kss), jnp.stack(vss), jnp.stack(css), jnp.stack(hss))
```

```cpp
#include <hip/hip_runtime.h>
__device__ __forceinline__ int lane_now() { int l; asm volatile("v_mbcnt_lo_u32_b32 %0, -1, 0\n\tv_mbcnt_hi_u32_b32 %0, -1, %0" : "=v"(l)); return l; }
#include <hip/hip_runtime.h>
#include <cstdio>
#include <cstdint>
namespace pg8 {
#define PG8_LAS __attribute__((address_space(3)))
typedef unsigned short bf16_t;
typedef short bf16x8 __attribute__((ext_vector_type(8)));
typedef float f32x4 __attribute__((ext_vector_type(4)));
typedef unsigned u32x4 __attribute__((ext_vector_type(4)));
constexpr int BM = 256, BK = 64, HALF = 128, HTB = HALF * BK * 2  , STAGE_BYTES = 8 * HTB, NXCD = 8, WGM = 8;

__host__ __device__ __forceinline__ int lds_byte(int r, int c) { const int st = (r >> 4) * 2 + (c >> 5), rr = r & 15, cc = c & 31, ob = rr * 64 + cc * 2; return st * 1024 + (ob ^ (((ob >> 9) & 1) << 5)); }
__host__ __device__ __forceinline__ void stage_rc(int b, int& R, int& C) { const int st = b / 1024, sb = b % 1024, swz = sb ^ (((sb >> 9) & 1) << 5); R = (st >> 1) * 16 + swz / 64; C = (st & 1) * 32 + (swz % 64) / 2; }
__host__ __device__ __forceinline__ int perm32(int rho) { const int n = rho >> 4, i = rho & 15; return 8 * (i >> 2) + 4 * n + (i & 3); }

struct Unit { int pm, pn; };
struct Gemm { const bf16_t* A; const bf16_t* Bt; int M, N, K; };

struct StaticOrder {
    int nM, nN, nwg, G, c;
    __host__ __device__ void init(int M, int N, int G_, int c_) { nM = M / BM; nN = N / BM; nwg = nM * nN; G = G_; c = c_; }
    __host__ __device__ bool next(int i, Unit& u) const {
        const long L = (long)i * G + c; if (L >= nwg) return false;
        int wgid = (int)L; { const int q = nwg / NXCD, r = nwg % NXCD, xcd = wgid % NXCD, off = wgid / NXCD; wgid = (xcd < r ? xcd * (q + 1) : r * (q + 1) + (xcd - r) * q) + off; }
        const int nig = WGM * nN, gid = wgid / nig, fm = gid * WGM, gsz = (nM - fm) < WGM ? (nM - fm) : WGM;
        u.pm = fm + ((wgid % nig) % gsz); u.pn = (wgid % nig) / gsz; return true;
    }
    __device__ __forceinline__ void a_ready(const Unit&) const {}
    __device__ __forceinline__ void done(const Unit&) const {}
};

typedef float f32x2 __attribute__((ext_vector_type(2)));
template <class Epi, class Sched, bool ALIGN_EPI = false, bool SP2 = false>
__device__ __forceinline__ void gemm_phase(PG8_LAS unsigned char* lds, const Gemm g, const Sched& S, const Epi& E) {
    const int tid = threadIdx.x, wid = __builtin_amdgcn_readfirstlane(tid >> 6), lane = tid & 63, wr = wid >> 2, wc = wid & 3, fr = lane & 15, fq = lane >> 4;
    const int K = g.K, nt = K / BK;
    unsigned voffA[2], voffB[2];
#pragma unroll
    for (int i = 0; i < 2; ++i) { int R, C; stage_rc(tid * 16 + i * 8192, R, C); const int Rb = Epi::PERM ? ((R & ~31) + perm32(R & 31)) : R;
        voffA[i] = (unsigned)(R * K + C) * 2u; voffB[i] = (unsigned)(Rb * K + C) * 2u; }
    const size_t kstep = (size_t)(BK * 2);
    const size_t hstep = (size_t)HALF * K * 2;
    const size_t tstep = 2 * hstep;
    const unsigned ldsw = (unsigned)wid * 1024u;
    const int aoff = lds_byte(wr * 64 + fr, fq * 8), boff = lds_byte(wc * 32 + fr, fq * 8);
#define PG8_SA(b, h) (((b) * 2 + (h)) * HTB)
#define PG8_SB(b, h) ((4 + (b) * 2 + (h)) * HTB)
#define PG8_STAGE(bufoff, gbase, voff) do { _Pragma("unroll") for (int _i = 0; _i < 2; ++_i) \
        __builtin_amdgcn_global_load_lds((const unsigned*)((const char*)(gbase) + (voff)[_i]), (PG8_LAS unsigned*)(lds + (bufoff) + ldsw + _i * 8192), 16, 0, 0); } while (0)
#define PG8_LDA(dst, b, h) do { _Pragma("unroll") for (int m = 0; m < 4; ++m) _Pragma("unroll") for (int k = 0; k < 2; ++k) dst[m][k] = *(const PG8_LAS bf16x8*)(lds + PG8_SA(b, h) + aoff + m * 2048 + k * 1024); } while (0)
#define PG8_LDB(dst, b, h) do { _Pragma("unroll") for (int n = 0; n < 2; ++n) _Pragma("unroll") for (int k = 0; k < 2; ++k) dst[n][k] = *(const PG8_LAS bf16x8*)(lds + PG8_SB(b, h) + boff + n * 2048 + k * 1024); } while (0)
#define PG8_MMA(ai, bj, At, Bt) do { __builtin_amdgcn_s_setprio(1); _Pragma("unroll") for (int m = 0; m < 4; ++m) _Pragma("unroll") for (int n = 0; n < 2; ++n) _Pragma("unroll") for (int k = 0; k < 2; ++k) \
        acc[ai][bj][m][n] = __builtin_amdgcn_mfma_f32_16x16x32_bf16(Bt[n][k], At[m][k], acc[ai][bj][m][n], 0, 0, 0); __builtin_amdgcn_s_setprio(0); } while (0)
#define PG8_WAIT_V(n) asm volatile("s_waitcnt vmcnt(" #n ")" ::: "memory")
#define PG8_WAIT_L(n) asm volatile("s_waitcnt lgkmcnt(" #n ")" ::: "memory")
#define PG8_BAR __builtin_amdgcn_s_barrier()
#define PG8_SCHED __builtin_amdgcn_sched_barrier(0)
    Unit cur, nxt; int ui = 0;
    if (!S.next(0, cur)) return;
    f32x4 acc[2][2][4][2];
#pragma unroll
    for (int a = 0; a < 2; ++a)
#pragma unroll
        for (int b = 0; b < 2; ++b)
#pragma unroll
            for (int m = 0; m < 4; ++m)
#pragma unroll
                for (int n = 0; n < 2; ++n) acc[a][b][m][n] = (f32x4){0.f, 0.f, 0.f, 0.f};
    bf16x8 At[4][2], B0[2][2], B1[2][2];
    const char* cA = (const char*)g.A + (size_t)cur.pm * tstep; const char* cB = (const char*)g.Bt + (size_t)cur.pn * tstep;
    S.a_ready(cur);
    if constexpr (SP2) {
        PG8_STAGE(PG8_SB(0, 0), cB, voffB); PG8_STAGE(PG8_SB(0, 1), cB + hstep, voffB); PG8_STAGE(PG8_SA(0, 0), cA, voffA); PG8_STAGE(PG8_SA(0, 1), cA + hstep, voffA);
        if (wr == 1) PG8_BAR;
        PG8_WAIT_V(2); PG8_BAR;
        PG8_STAGE(PG8_SB(1, 0), cB + kstep, voffB); PG8_STAGE(PG8_SA(1, 0), cA + kstep, voffA); PG8_STAGE(PG8_SB(1, 1), cB + hstep + kstep, voffB);
        PG8_WAIT_V(6); PG8_BAR;
    } else {
        PG8_STAGE(PG8_SB(0, 0), cB, voffB); PG8_STAGE(PG8_SA(0, 0), cA, voffA); PG8_STAGE(PG8_SB(0, 1), cB + hstep, voffB); PG8_STAGE(PG8_SA(0, 1), cA + hstep, voffA);
        if (wr == 1) PG8_BAR;
        PG8_WAIT_V(4); PG8_BAR;
        PG8_STAGE(PG8_SB(1, 0), cB + kstep, voffB); PG8_STAGE(PG8_SA(1, 0), cA + kstep, voffA); PG8_STAGE(PG8_SB(1, 1), cB + hstep + kstep, voffB);
        PG8_WAIT_V(6); PG8_BAR;
    }
    for (;;) {
        const bool has_next = S.next(ui + 1, nxt);
        const char* nA = has_next ? (const char*)g.A + (size_t)nxt.pm * tstep : cA; const char* nB = has_next ? (const char*)g.Bt + (size_t)nxt.pn * tstep : cB;
        for (int t = 0; t < nt; t += 2) {
            const bool last = (t == nt - 2);
            const char* a1 = cA + (size_t)(t + 1) * kstep;
            const char* a2 = last ? nA : cA + (size_t)(t + 2) * kstep; const char* b2 = last ? nB : cB + (size_t)(t + 2) * kstep;
            const char* a3 = a2 + kstep; const char* b3 = b2 + kstep;
            if (last && has_next) S.a_ready(nxt);
            if constexpr (SP2) {
            PG8_LDB(B0, 0, 0); PG8_LDB(B1, 0, 1); PG8_SCHED; PG8_LDA(At, 0, 0); PG8_STAGE(PG8_SA(1, 1), a1 + hstep, voffA);
            PG8_WAIT_V(8); PG8_WAIT_L(0); PG8_BAR; PG8_MMA(0, 0, At, B0); PG8_MMA(0, 1, At, B1); PG8_BAR; PG8_SCHED;
            PG8_LDA(At, 0, 1); PG8_STAGE(PG8_SB(0, 0), b2, voffB); PG8_STAGE(PG8_SB(0, 1), b2 + hstep, voffB); PG8_STAGE(PG8_SA(0, 0), a2, voffA);
            PG8_WAIT_V(8); PG8_WAIT_L(0); PG8_BAR; PG8_MMA(1, 0, At, B0); PG8_MMA(1, 1, At, B1); PG8_BAR; PG8_SCHED;
            PG8_LDB(B0, 1, 0); PG8_LDB(B1, 1, 1); PG8_SCHED; PG8_LDA(At, 1, 0); PG8_STAGE(PG8_SA(0, 1), a2 + hstep, voffA);
            PG8_WAIT_V(8); PG8_WAIT_L(0); PG8_BAR; PG8_MMA(0, 0, At, B0); PG8_MMA(0, 1, At, B1); PG8_BAR; PG8_SCHED;
            PG8_LDA(At, 1, 1); PG8_STAGE(PG8_SB(1, 0), b3, voffB); PG8_STAGE(PG8_SB(1, 1), b3 + hstep, voffB); PG8_STAGE(PG8_SA(1, 0), a3, voffA);
            PG8_WAIT_V(8); PG8_WAIT_L(0); PG8_BAR; PG8_MMA(1, 0, At, B0); PG8_MMA(1, 1, At, B1); PG8_BAR; PG8_SCHED;
            } else {
            PG8_LDB(B0, 0, 0); PG8_SCHED; PG8_LDA(At, 0, 0); PG8_STAGE(PG8_SA(1, 1), a1 + hstep, voffA);
            PG8_WAIT_L(8); PG8_BAR; PG8_WAIT_L(0); PG8_MMA(0, 0, At, B0); PG8_BAR; PG8_SCHED;
            PG8_LDB(B1, 0, 1); PG8_STAGE(PG8_SB(0, 0), b2, voffB);
            PG8_BAR; PG8_WAIT_L(0); PG8_MMA(0, 1, At, B1); PG8_BAR;
            PG8_LDA(At, 0, 1); PG8_STAGE(PG8_SA(0, 0), a2, voffA);
            PG8_BAR; PG8_WAIT_L(0); PG8_MMA(1, 0, At, B0); PG8_BAR; PG8_SCHED;
            PG8_STAGE(PG8_SB(0, 1), b2 + hstep, voffB);
            PG8_WAIT_V(6); PG8_BAR; PG8_MMA(1, 1, At, B1); PG8_BAR;
            PG8_LDB(B0, 1, 0); PG8_SCHED; PG8_LDA(At, 1, 0); PG8_STAGE(PG8_SA(0, 1), a2 + hstep, voffA);
            PG8_WAIT_L(8); PG8_BAR; PG8_WAIT_L(0); PG8_MMA(0, 0, At, B0); PG8_BAR; PG8_SCHED;
            PG8_LDB(B1, 1, 1); PG8_STAGE(PG8_SB(1, 0), b3, voffB);
            PG8_BAR; PG8_WAIT_L(0); PG8_MMA(0, 1, At, B1); PG8_BAR;
            PG8_LDA(At, 1, 1); PG8_STAGE(PG8_SA(1, 0), a3, voffA);
            PG8_BAR; PG8_WAIT_L(0); PG8_MMA(1, 0, At, B0); PG8_BAR; PG8_SCHED;
            PG8_STAGE(PG8_SB(1, 1), b3 + hstep, voffB);
            PG8_WAIT_V(6); PG8_BAR; PG8_MMA(1, 1, At, B1); PG8_BAR;
            }
        }
        if constexpr (ALIGN_EPI) { if (wr == 0) PG8_BAR; }
        if constexpr (!Epi::AFTER_DRAIN) { E(acc, cur, wr, wc, fr, fq); S.done(cur); }
        if (!has_next) break;
#pragma unroll
        for (int a = 0; a < 2; ++a)
#pragma unroll
            for (int b = 0; b < 2; ++b)
#pragma unroll
                for (int m = 0; m < 4; ++m)
#pragma unroll
                    for (int n = 0; n < 2; ++n) acc[a][b][m][n] = (f32x4){0.f, 0.f, 0.f, 0.f};
        cur = nxt; cA = nA; cB = nB; ++ui;
        if constexpr (ALIGN_EPI) { if (wr == 1) PG8_BAR; }
    }
    PG8_WAIT_V(0);
    if constexpr (!ALIGN_EPI) { if (wr == 0) PG8_BAR; }
    PG8_BAR;
    if constexpr (Epi::AFTER_DRAIN) { E.fused(acc, cur, wr, wc, fr, fq, lds, wid, lane); S.done(cur); }
#undef PG8_SA
#undef PG8_SB
#undef PG8_STAGE
#undef PG8_LDA
#undef PG8_LDB
#undef PG8_MMA
#undef PG8_WAIT_V
#undef PG8_WAIT_L
#undef PG8_BAR
#undef PG8_SCHED
}
}

#include <hip/hip_bf16.h>
#include <cmath>
namespace attn_body {
using bf16=__hip_bfloat16;
using bf16x8=__attribute__((ext_vector_type(8)))short;
using s16x4=__attribute__((ext_vector_type(4)))short;
using f32x16=__attribute__((ext_vector_type(16)))float;
using u32x4=__attribute__((ext_vector_type(4)))unsigned;
constexpr int BATCH=2,NHEAD=16,SEQ=8192,D=64,PQ=512,PO=1024;
constexpr int NW=8,QBLK=32,QB=QBLK*NW,KVBLK=64,NQB=SEQ/QB;
constexpr int ATTN_UNIT_ROWS=QB;
__device__ __forceinline__ int crow(int r,int hi){return (r&3)+8*(r>>2)+4*hi;}
#define SBAR() __builtin_amdgcn_sched_barrier(0)
__device__ __forceinline__ void cmask(f32x16&p0,f32x16&p1,int jb,int qrel,int hi){
  const float NEG=-INFINITY; int kb=64*jb+4*hi;
  #pragma unroll
  for(int r=0;r<16;++r){int kv=kb+(r&3)+8*(r>>2); if(kv>qrel)p0[r]=NEG; if(kv+32>qrel)p1[r]=NEG;}
}

constexpr int NSLOT=3, SLOTB=8192;
constexpr int LDS_K=0, LDS_V=NSLOT*SLOTB, LDS_WS=2*NSLOT*SLOTB, LDS_OST=LDS_WS+NW*64*4, LDS_BYTES=LDS_OST+NW*4096;
constexpr float C2=0.125f*1.4426950408889634f;
__device__ __forceinline__ void glds16(const void*gsrc,unsigned lds_dst){unsigned keep;
  asm volatile("s_mov_b32 %0, m0\n\ts_mov_b32 m0, %2\n\ts_nop 0\n\tglobal_load_lds_dwordx4 %1, off\n\ts_mov_b32 m0, %0":"=&s"(keep):"v"(gsrc),"s"(lds_dst):"memory");}
__device__ __forceinline__ float max3f(float a,float b,float c){float r;asm("v_max3_f32 %0, %1, %2, %3":"=v"(r):"v"(a),"v"(b),"v"(c));return r;}
__device__ __forceinline__ float max2f(float a,float b){float r;asm("v_max_f32_e32 %0, %1, %2":"=v"(r):"v"(a),"v"(b));return r;}
__device__ __forceinline__ float fadd_s(float a,float b){float r;asm("v_add_f32_e32 %0, %1, %2":"=v"(r):"v"(a),"v"(b));return r;}
__device__ __forceinline__ float fsub_s(float a,float b){float r;asm("v_sub_f32_e32 %0, %1, %2":"=v"(r):"v"(a),"v"(b));return r;}
typedef float f32x2_t __attribute__((ext_vector_type(2))); typedef __bf16 bf16x2_t __attribute__((ext_vector_type(2)));
__device__ __forceinline__ unsigned cvtpk_s(float lo,float hi){f32x2_t v={lo,hi};bf16x2_t b=__builtin_convertvector(v,bf16x2_t);return __builtin_bit_cast(unsigned,b);}
#define WAIT_BAR(N) asm volatile("s_waitcnt vmcnt(" #N ") lgkmcnt(0)\n\ts_barrier":::"memory")

__device__ __forceinline__ void qkt(f32x16&p0,f32x16&p1,const char*Kslot,const bf16x8*qr,const f32x16&negm,int r32,int hi){
  const char*kb=Kslot+hi*1024+r32*16;
  #pragma unroll
  for(int d0=0;d0<4;++d0){
    const bf16x8 b0=*reinterpret_cast<const bf16x8*>(kb+d0*2048);
    const bf16x8 b1=*reinterpret_cast<const bf16x8*>(kb+d0*2048+512);
    if(d0==0){p0=__builtin_amdgcn_mfma_f32_32x32x16_bf16(b0,qr[0],negm,0,0,0);p1=__builtin_amdgcn_mfma_f32_32x32x16_bf16(b1,qr[0],negm,0,0,0);}
    else{p0=__builtin_amdgcn_mfma_f32_32x32x16_bf16(b0,qr[d0],p0,0,0,0);p1=__builtin_amdgcn_mfma_f32_32x32x16_bf16(b1,qr[d0],p1,0,0,0);}}
}
typedef __attribute__((address_space(3))) const char* lds_cptr;
typedef short v4i16_t __attribute__((ext_vector_type(4)));
__device__ __forceinline__ void kload8(bf16x8*kf,lds_cptr kp){
  kf[0]=*(const __attribute__((address_space(3))) bf16x8*)(kp);      kf[1]=*(const __attribute__((address_space(3))) bf16x8*)(kp+512);
  kf[2]=*(const __attribute__((address_space(3))) bf16x8*)(kp+2048); kf[3]=*(const __attribute__((address_space(3))) bf16x8*)(kp+2560);
  kf[4]=*(const __attribute__((address_space(3))) bf16x8*)(kp+4096); kf[5]=*(const __attribute__((address_space(3))) bf16x8*)(kp+4608);
  kf[6]=*(const __attribute__((address_space(3))) bf16x8*)(kp+6144); kf[7]=*(const __attribute__((address_space(3))) bf16x8*)(kp+6656);
}
__device__ __forceinline__ void kload2(bf16x8*kf,lds_cptr kp,int j){ kf[2*j]=*(const __attribute__((address_space(3))) bf16x8*)(kp+j*2048); kf[2*j+1]=*(const __attribute__((address_space(3))) bf16x8*)(kp+j*2048+512); }
__device__ __forceinline__ s16x4 vtr(lds_cptr p){ return __builtin_bit_cast(s16x4,__builtin_amdgcn_ds_read_tr16_b64_v4i16((__attribute__((address_space(3))) v4i16_t*)p)); }
__device__ __forceinline__ float rowmax(const f32x16&p0,const f32x16&p1){
  float a=max3f(p0[0],p0[1],p1[0]),b=max3f(p0[2],p0[3],p1[1]);a=max3f(a,p1[2],p1[3]);
  #pragma unroll
  for(int r=4;r<16;r+=4){a=max3f(a,p0[r],p0[r+1]);b=max3f(b,p0[r+2],p0[r+3]);a=max3f(a,p1[r],p1[r+1]);b=max3f(b,p1[r+2],p1[r+3]);}
  const float m=max2f(a,b);
  auto rr=__builtin_amdgcn_permlane32_swap(__float_as_uint(m),__float_as_uint(m),false,false);
  return max2f(__uint_as_float(rr[0]),__uint_as_float(rr[1]));
}
__device__ __forceinline__ void pv(f32x16*o,int vb,bf16x8 pa0,bf16x8 pa1,bf16x8 pa2,bf16x8 pa3){
  #pragma unroll
  for(int d0=0;d0<2;++d0){s16x4 lo[4],hi[4];
    #pragma unroll
    for(int ks=0;ks<4;++ks){
      asm volatile("ds_read_b64_tr_b16 %0,%1 offset:%c2":"=&v"(lo[ks]):"v"(vb),"i"(d0*4096+ks*1024):"memory");
      asm volatile("ds_read_b64_tr_b16 %0,%1 offset:%c2":"=&v"(hi[ks]):"v"(vb),"i"(d0*4096+ks*1024+512):"memory");}
    asm volatile("s_waitcnt lgkmcnt(0)":::"memory");SBAR();
    #define PK(k) (bf16x8){lo[k][0],lo[k][1],lo[k][2],lo[k][3],hi[k][0],hi[k][1],hi[k][2],hi[k][3]}
    o[d0]=__builtin_amdgcn_mfma_f32_32x32x16_bf16(pa0,PK(0),o[d0],0,0,0);
    o[d0]=__builtin_amdgcn_mfma_f32_32x32x16_bf16(pa1,PK(1),o[d0],0,0,0);
    o[d0]=__builtin_amdgcn_mfma_f32_32x32x16_bf16(pa2,PK(2),o[d0],0,0,0);
    o[d0]=__builtin_amdgcn_mfma_f32_32x32x16_bf16(pa3,PK(3),o[d0],0,0,0);
    #undef PK
  }
}

#ifndef ATTN_STORE16
#define ATTN_STORE16(p,v) (*(u32x4*)(p)=(v))
#endif
template<int THRL> __device__ __forceinline__ void attn_unit(int b,int qoff,int koff,int voff,int ooff,int qb,const bf16*Q,const bf16*__restrict__ K,const bf16*__restrict__ V,bf16*O,char*shm){
  const int tid=threadIdx.x,lane=tid&63,r32=lane&31,hi=lane>>5; const int wid=__builtin_amdgcn_readfirstlane(tid>>6);
  const long rowbase=(long)b*SEQ; const int q0=qb*QB;
  const bf16*Qw=Q+(rowbase+q0+wid*QBLK)*PQ+qoff;
  const bf16*Kh=K+rowbase*PQ+koff,*Vh=V+rowbase*PQ+voff;
  const unsigned lds0=(unsigned)(uintptr_t)shm;
  float*wsf=(float*)(shm+LDS_WS)+wid*64;
  const bf16*ksrc=Kh+(long)lane*PQ+wid*8;
  const bf16*vsrc=Vh+(long)(16*(wid&3)+(lane>>2))*PQ+(wid>>2)*32+(lane&3)*8;
  const unsigned kdst=lds0+LDS_K+wid*1024, vdst=lds0+LDS_V+wid*1024;
  #define DMA_K(t,slot) glds16(ksrc+(long)(t)*KVBLK*PQ,(unsigned)__builtin_amdgcn_readfirstlane(kdst+(slot)))
  #define DMA_V(t,slot) glds16(vsrc+(long)(t)*KVBLK*PQ,(unsigned)__builtin_amdgcn_readfirstlane(vdst+(slot)))
  const int vb0=(int)(lds0+LDS_V)+((lane>>4)&1)*32+(lane&3)*8+(4*hi+((lane&15)>>2))*64;
  const char*Kbase=shm+LDS_K; bf16x8 kf[8];
  const lds_cptr shm3=(lds_cptr)shm; const lds_cptr kp0=shm3+LDS_K+hi*1024+r32*16; const lds_cptr vp0=shm3+LDS_V+((lane>>4)&1)*32+(lane&3)*8+(4*hi+((lane&15)>>2))*64;
  const int NT=(q0+QB)/KVBLK;
  DMA_K(0,0);DMA_V(0,0);DMA_K(1,SLOTB);
  bf16x8 qr[4];
  #pragma unroll
  for(int d0=0;d0<4;++d0)qr[d0]=*reinterpret_cast<const bf16x8*>(&Qw[(long)r32*PQ+d0*16+hi*8]);
  float mhat=0.f,l_reg=0.f;f32x16 o[2];o[0]=f32x16{};o[1]=f32x16{};f32x16 negm=f32x16{};asm volatile("":"+v"(negm));
  const int qrel=wid*QBLK+r32;
  #define CMASK(P0,P1,t) do{int jb_=(t)-(NT-4); if(jb_>=0)cmask(P0,P1,jb_,qrel,hi);}while(0)
  bool resc=false;
  #define START(P0,P1) do{ const float rm=rowmax(P0,P1); resc=false; \
    { const float dl=rm; mhat=fadd_s(mhat,dl); \
      _Pragma("unroll") for(int r=0;r<16;++r){P0[r]=fsub_s(P0[r],dl);P1[r]=fsub_s(P1[r],dl);} \
      _Pragma("unroll") for(int r=0;r<16;++r)negm[r]=-mhat; asm volatile("":"+v"(negm)); } \
    _Pragma("unroll") for(int r=0;r<16;++r)P0[r]=__builtin_amdgcn_exp2f(P0[r]); }while(0)
  #define RESC() do{ if(resc){ asm volatile("s_waitcnt lgkmcnt(0)":::"memory"); \
      _Pragma("unroll") for(int d_=0;d_<2;++d_) _Pragma("unroll") for(int r=0;r<16;++r)o[d_][r]*=wsf[crow(r,hi)]; } }while(0)
  f32x16 pA0,pA1,pB0,pB1;
  int sl_prev=0,sl_cur=0,sl_next=SLOTB;
  #define ROT() do{sl_prev=sl_cur;sl_cur=sl_next;sl_next=(sl_next==(NSLOT-1)*SLOTB)?0:sl_next+SLOTB;}while(0)
  DMA_K(2,2*SLOTB);
  WAIT_BAR(3);
  qkt(pA0,pA1,Kbase,qr,negm,r32,hi);asm volatile("s_nop 15\n\ts_nop 7":"+v"(pA0),"+v"(pA1));CMASK(pA0,pA1,0);
  START(pA0,pA1);
  _Pragma("unroll") for(int r=0;r<16;++r)pA1[r]=__builtin_amdgcn_exp2f(pA1[r]);
  WAIT_BAR(0);
  DMA_K(3,0);DMA_V(1,SLOTB);
  ROT();
  kload8(kf,kp0+sl_cur);
  WAIT_BAR(2);
  s16x4 vlo[8],vhi[8]; u32x4 pw0,pw1,pw2,pw3;
  #define PKW(P,B) cvtpk_s(P[B],P[B+1])
  #define PAF(k) __builtin_bit_cast(bf16x8,pw##k)
  #define VFR(i) (bf16x8){vlo[i][0],vlo[i][1],vlo[i][2],vlo[i][3],vhi[i][0],vhi[i][1],vhi[i][2],vhi[i][3]}
  #define PIN(x) asm volatile("":"+v"(x))
  #define MX3(a,b,c) __builtin_fmaxf(__builtin_fmaxf((a),(b)),(c))
  #define GAPA(MF,A0,A1,A2,A3,W0,W1,PW) do{ MF; sacc+=A0; sacc+=A1; sacc+=A2; sacc+=A3; PIN(sacc); W0; W1; PIN(PW); SBAR(); }while(0)
  #define EX(v) __builtin_amdgcn_exp2f(v)
  #define GAPB(MF,X,B) do{ MF; X[B]=EX(X[B]); X[B+1]=EX(X[B+1]); X[B+2]=EX(X[B+2]); X[B+3]=EX(X[B+3]); PIN(X); SBAR(); }while(0)
  #define VRD(i) do{ vlo[i]=vtr(vp_+(((i)>>2)*4096+((i)&3)*1024)); vhi[i]=vtr(vp_+(((i)>>2)*4096+((i)&3)*1024+512)); }while(0)
  #define KRD(G,j) do{ if(G){ kload2(kf,kp0+sl_next,j); SBAR(); } }while(0)
  #define STEP(C0,C1,P0,P1,t,GK,GV,GL) do{ SBAR(); \
    const lds_cptr vp_=vp0+sl_prev; \
    VRD(0); SBAR(); float sacc=(P0[0]+P0[1]); \
    GAPA(C0=__builtin_amdgcn_mfma_f32_32x32x16_bf16(kf[0],qr[0],negm,0,0,0), P0[2],P0[3],P0[4],P0[5],     pw0[0]=PKW(P0,0), pw0[1]=PKW(P0,2), pw0); \
    VRD(4); SBAR(); GAPA(C1=__builtin_amdgcn_mfma_f32_32x32x16_bf16(kf[1],qr[0],negm,0,0,0), P0[6],P0[7],P0[8],P0[9],     pw0[2]=PKW(P0,4), pw0[3]=PKW(P0,6), pw0); \
    VRD(1); SBAR(); GAPA(C0=__builtin_amdgcn_mfma_f32_32x32x16_bf16(kf[2],qr[1],C0,0,0,0),   P0[10],P0[11],P0[12],P0[13], pw1[0]=PKW(P0,8), pw1[1]=PKW(P0,10), pw1); \
    VRD(5); SBAR(); GAPA(C1=__builtin_amdgcn_mfma_f32_32x32x16_bf16(kf[3],qr[1],C1,0,0,0),   P0[14],P0[15],P1[0],P1[1],   pw1[2]=PKW(P0,12),pw1[3]=PKW(P0,14), pw1); \
    VRD(2); SBAR(); GAPA(C0=__builtin_amdgcn_mfma_f32_32x32x16_bf16(kf[4],qr[2],C0,0,0,0),   P1[2],P1[3],P1[4],P1[5],     pw2[0]=PKW(P1,0), pw2[1]=PKW(P1,2), pw2); \
    VRD(6); SBAR(); GAPA(C1=__builtin_amdgcn_mfma_f32_32x32x16_bf16(kf[5],qr[2],C1,0,0,0),   P1[6],P1[7],P1[8],P1[9],     pw2[2]=PKW(P1,4), pw2[3]=PKW(P1,6), pw2); \
    VRD(3); SBAR(); GAPA(C0=__builtin_amdgcn_mfma_f32_32x32x16_bf16(kf[6],qr[3],C0,0,0,0),   P1[10],P1[11],P1[12],P1[13], pw3[0]=PKW(P1,8), pw3[1]=PKW(P1,10), pw3); \
    VRD(7); SBAR(); GAPA(C1=__builtin_amdgcn_mfma_f32_32x32x16_bf16(kf[7],qr[3],C1,0,0,0),   P1[14],P1[15],0.f,0.f,       pw3[2]=PKW(P1,12),pw3[3]=PKW(P1,14), pw3); \
    l_reg+=sacc; \
    if(GK){DMA_K((t)+3,sl_cur);} if(GV){DMA_V((t)+1,sl_next);} \
    CMASK(C0,C1,t); \
    { float a=MX3(C0[0],C0[1],C1[0]),b=MX3(C0[2],C0[3],C1[1]); a=MX3(a,C1[2],C1[3]); \
      _Pragma("unroll") for(int r=4;r<16;r+=4){a=MX3(a,C0[r],C0[r+1]);b=MX3(b,C0[r+2],C0[r+3]);a=MX3(a,C1[r],C1[r+1]);b=MX3(b,C1[r+2],C1[r+3]);} \
      float rm=__builtin_fmaxf(a,b); { auto rr=__builtin_amdgcn_permlane32_swap(__float_as_uint(rm),__float_as_uint(rm),false,false); rm=__builtin_fmaxf(__uint_as_float(rr[0]),__uint_as_float(rr[1])); } \
      resc=false; \
      if(__builtin_expect(__any(rm>(float)THRL),0)){ const float dl=__builtin_fmaxf(rm,0.f); mhat+=dl; \
        _Pragma("unroll") for(int r=0;r<16;++r){C0[r]-=dl;C1[r]-=dl;} \
        _Pragma("unroll") for(int r=0;r<16;++r)negm[r]=-mhat; asm volatile("":"+v"(negm)); \
        const float f=__builtin_amdgcn_exp2f(-dl); l_reg*=f; if(hi==0)wsf[r32]=f; resc=true; } } \
    SBAR(); \
    GAPB(o[0]=__builtin_amdgcn_mfma_f32_32x32x16_bf16(PAF(0),VFR(0),o[0],0,0,0), C0,0); \
    GAPB(o[1]=__builtin_amdgcn_mfma_f32_32x32x16_bf16(PAF(0),VFR(4),o[1],0,0,0), C0,4); \
    KRD(GL,0); GAPB(o[0]=__builtin_amdgcn_mfma_f32_32x32x16_bf16(PAF(1),VFR(1),o[0],0,0,0), C0,8); \
    KRD(GL,1); GAPB(o[1]=__builtin_amdgcn_mfma_f32_32x32x16_bf16(PAF(1),VFR(5),o[1],0,0,0), C0,12); \
    KRD(GL,2); GAPB(o[0]=__builtin_amdgcn_mfma_f32_32x32x16_bf16(PAF(2),VFR(2),o[0],0,0,0), C1,0); \
    KRD(GL,3); GAPB(o[1]=__builtin_amdgcn_mfma_f32_32x32x16_bf16(PAF(2),VFR(6),o[1],0,0,0), C1,4); \
    GAPB(o[0]=__builtin_amdgcn_mfma_f32_32x32x16_bf16(PAF(3),VFR(3),o[0],0,0,0), C1,8); \
    GAPB(o[1]=__builtin_amdgcn_mfma_f32_32x32x16_bf16(PAF(3),VFR(7),o[1],0,0,0), C1,12); \
    }while(0)
  int t=1;
  #undef CMASK
  #define CMASK(P0,P1,t) do{}while(0)
  for(;t+5<NT;t+=2){
    STEP(pB0,pB1,pA0,pA1,t,true,true,true);     WAIT_BAR(2); RESC(); ROT();
    STEP(pA0,pA1,pB0,pB1,t+1,true,true,true);   WAIT_BAR(2); RESC(); ROT();
  }
  #undef CMASK
  #define CMASK(P0,P1,t) do{int jb_=(t)-(NT-4); if(jb_>=0)cmask(P0,P1,jb_,qrel,hi);}while(0)
  #define ENDW(tt) do{ if((tt)+3<NT){WAIT_BAR(2);} else if((tt)+2<NT){WAIT_BAR(1);} else {WAIT_BAR(0);} }while(0)
  for(;t+1<NT;t+=2){
    STEP(pB0,pB1,pA0,pA1,t,(t+3<NT),(t+1<NT),(t+1<NT));       ENDW(t);   RESC(); ROT();
    STEP(pA0,pA1,pB0,pB1,t+1,(t+4<NT),(t+2<NT),(t+2<NT));     ENDW(t+1); RESC(); ROT();
  }
  STEP(pB0,pB1,pA0,pA1,NT-1,false,false,false); RESC();
  { float sacc=pB0[0]+pB0[1]; _Pragma("unroll") for(int r=2;r<16;++r)sacc+=pB0[r]; _Pragma("unroll") for(int r=0;r<16;++r)sacc+=pB1[r]; l_reg+=sacc;
    pw0=(u32x4){PKW(pB0,0),PKW(pB0,2),PKW(pB0,4),PKW(pB0,6)};pw1=(u32x4){PKW(pB0,8),PKW(pB0,10),PKW(pB0,12),PKW(pB0,14)};pw2=(u32x4){PKW(pB1,0),PKW(pB1,2),PKW(pB1,4),PKW(pB1,6)};pw3=(u32x4){PKW(pB1,8),PKW(pB1,10),PKW(pB1,12),PKW(pB1,14)};
    SBAR(); pv(o,vb0+sl_cur,PAF(0),PAF(1),PAF(2),PAF(3)); }
  #undef PKW
  #undef PAF
  #undef VFR
  #undef PIN
  #undef MX3
  #undef GAPA
  #undef GAPB
  #undef EX
  #undef VRD
  #undef KRD
  #undef STEP
  #undef ENDW
  {auto rr=__builtin_amdgcn_permlane32_swap(__float_as_uint(l_reg),__float_as_uint(l_reg),false,false);l_reg=__uint_as_float(rr[0])+__uint_as_float(rr[1]);}
  if(hi==0)wsf[32+r32]=l_reg;asm volatile("s_waitcnt lgkmcnt(0)":::"memory");
  float rli[16];
  #pragma unroll
  for(int r=0;r<16;++r)rli[r]=__builtin_amdgcn_rcpf(wsf[32+crow(r,hi)]);
  bf16*Ow=O+(rowbase+q0+wid*QBLK)*PO+ooff;
  { bf16*stg=(bf16*)(shm+LDS_OST)+wid*2048;
    #pragma unroll
    for(int r=0;r<16;++r){const int orow=crow(r,hi);
      #pragma unroll
      for(int d0=0;d0<2;++d0)stg[orow*64+d0*32+r32]=__float2bfloat16(o[d0][r]*rli[r]);}
    asm volatile("s_waitcnt lgkmcnt(0)":::"memory");
    #pragma unroll
    for(int i=0;i<4;++i){const int row=i*8+(lane>>3),ch=lane&7; const u32x4 v=*(const u32x4*)(stg+row*64+ch*8); ATTN_STORE16(Ow+(long)row*PO+ch*8,v);} }
  asm volatile("s_waitcnt lgkmcnt(0)\n\ts_barrier":::"memory");
  #undef DMA_K
  #undef DMA_V
  #undef CMASK
  #undef START
  #undef RESC
  #undef ROT
}
constexpr int ATTN_LDS_BYTES=LDS_BYTES;
struct AttnTensors { const bf16* Q; const bf16* K; const bf16* V; bf16* O; };
struct AttnUnit { int bh; int qb; };
struct StaticOrder {
  int vcu;
  __device__ __forceinline__ explicit StaticOrder(int grid,int block):vcu((block%8)*(grid/8)+block/8){}
  __device__ __forceinline__ bool next(int i,AttnUnit&u)const{ if(i>=4)return false; const int s=vcu&7; u.bh=vcu>>3; u.qb=(i==0)?s:(i==1)?15-s:(i==2)?16+s:31-s; return true; }
  __device__ __forceinline__ void a_ready(const AttnUnit&)const{}
  __device__ __forceinline__ void done(const AttnUnit&)const{}
};
template<class Sched,int THRL=8> __device__ __forceinline__ void attn_phase(char*lds,const AttnTensors&T,const Sched&S){
  AttnUnit u;
  for(int i=0;S.next(i,u);++i){ S.a_ready(u); const int b=u.bh/NHEAD, vh=u.bh%NHEAD, hh=vh>>2, mi=(vh>>1)&1, vj=vh&1; attn_unit<THRL>(b,hh*128+mi*64,hh*128+mi*64,hh*128+vj*64,mi*512+hh*128+vj*64,u.qb,T.Q,T.K,T.V,T.O,lds); S.done(u); }
}
#undef SBAR
#undef WAIT_BAR
}

constexpr int NWAVES = 8;
constexpr int DM = 1024, TSEQ = 8192, NBATCH = 2, MP = NBATCH * TSEQ, MS = 128, MTOT = MP + MS, MROWS = 16640;
constexpr int LW = 512, AW = 512, INW = 2560, FF = 2816, GU = 2 * FF, PLE = 256, NPAGE = 16, PAGE = 128, PASTLEN = 2048;
constexpr float LAM_INIT = 0.2f, SUBLN_SCALE = 0.8f;
constexpr float C2 = 0.125f * 1.4426950408889634f;
constexpr int CHUNK = 64, NCHUNK = MP / CHUNK;

constexpr size_t OY_P = 0, OY_S = OY_P + (size_t)MP * DM, OK_P = OY_S + (size_t)MS * DM, OV_P = OK_P + (size_t)MP * AW, OC_P = OV_P + (size_t)MP * AW,
                 OH_P = OC_P + (size_t)NBATCH * 3 * LW, OK_S = OH_P + (size_t)NBATCH * LW, OV_S = OK_S + (size_t)MS * AW, OC_S = OV_S + (size_t)MS * AW,
                 OH_S = OC_S + (size_t)MS * 3 * LW, OUT_TOTAL = OH_S + (size_t)MS * LW;
static_assert(OUT_TOTAL == 34082816, "d_out map");

constexpr size_t MiB = 1u << 20;
constexpr size_t al4k(size_t x) { return (x + 4095) & ~(size_t)4095; }
constexpr size_t WS_CTL = 0, CTL_ZERO_BYTES = 1 * MiB;
constexpr size_t WS_WIN  = 1 * MiB;
constexpr size_t WS_WOUT = WS_WIN  + al4k((size_t)INW * DM * 2);
constexpr size_t WS_WGU  = WS_WOUT + al4k((size_t)DM * DM * 2);
constexpr size_t WS_WD   = WS_WGU  + al4k((size_t)GU * DM * 2);
constexpr size_t WS_WPG  = WS_WD   + al4k((size_t)DM * FF * 2);
constexpr size_t WS_WPP  = WS_WPG  + al4k((size_t)DM * DM * 2);
constexpr size_t WS_WLRU = WS_WPP  + al4k((size_t)DM * PLE * 2);
constexpr size_t WS_ROPE = WS_WLRU + al4k((size_t)2 * 8 * 64 * 64 * 2);
constexpr size_t WS_XN   = WS_ROPE + al4k((size_t)TSEQ * 16 * 4);
constexpr size_t WS_PB   = WS_XN   + al4k((size_t)MROWS * DM * 2);
constexpr size_t WS_XL   = WS_PB   + al4k((size_t)MROWS * PLE * 2);
constexpr size_t WS_GG   = WS_XL   + al4k((size_t)MP * LW * 4);
constexpr size_t WS_Q    = WS_GG   + al4k((size_t)MP * LW * 2);
constexpr size_t WS_K    = WS_Q    + al4k((size_t)MP * AW * 2);
constexpr size_t WS_V    = WS_K    + al4k((size_t)MP * AW * 2);
constexpr size_t WS_O    = WS_V    + al4k((size_t)MP * AW * 2);
constexpr size_t WS_HL   = WS_O    + al4k((size_t)MP * 2 * AW * 2);
constexpr size_t WS_PC   = WS_HL   + al4k((size_t)MP * LW * 4);
constexpr size_t WS_CHS  = WS_PC   + al4k((size_t)MP * LW * 4);
constexpr size_t WS_AMIX = WS_CHS  + al4k((size_t)NCHUNK * 2 * LW * 4);
constexpr size_t WS_MIX  = WS_AMIX + al4k((size_t)MROWS * DM * 2);
constexpr size_t WS_X1   = WS_MIX  + al4k((size_t)MROWS * DM * 4);
constexpr size_t WS_HB   = WS_X1   + al4k((size_t)MROWS * DM * 4);
constexpr size_t WS_PROJ = WS_HB   + al4k((size_t)MP * FF * 2);
constexpr size_t WS_US   = WS_PROJ + al4k((size_t)MP * DM * 2);
constexpr size_t WS_GUS  = WS_US   + al4k((size_t)MS * INW * 4);
constexpr size_t WS_GS   = WS_GUS  + al4k((size_t)MS * GU * 4);
constexpr size_t WS_PJS  = WS_GS   + al4k((size_t)MS * DM * 4);
constexpr size_t WS_QS   = WS_PJS  + al4k((size_t)MS * DM * 4);
constexpr size_t DP_STRIDE = 2 * 132;
constexpr size_t WS_DP   = WS_QS   + al4k((size_t)MS * AW * 4);
constexpr size_t WS_END  = WS_DP   + al4k((size_t)MS * 2 * 4 * DP_STRIDE * 4);
constexpr int CW_TMO = 0, CW_CODE = 1, CW_DBG = 64;
constexpr int CW_BAR = 4096;

constexpr int RING_OFF = 0, RING_BYTES = 131072;
constexpr int LDSCTL_OFF = RING_BYTES, MISC_OFF = LDSCTL_OFF + 320;
constexpr int LDS_BYTES = 147456;
static_assert(MISC_OFF + 128 <= LDS_BYTES, "LDS map");

#define GAS __attribute__((address_space(1)))
#define LAS __attribute__((address_space(3)))
typedef unsigned short bf16;
typedef unsigned v4u __attribute__((ext_vector_type(4)));
typedef float f32x4 __attribute__((ext_vector_type(4)));
typedef short bf16x8 __attribute__((ext_vector_type(8)));
typedef GAS unsigned gu32;
typedef GAS unsigned long long gu64;
#define RLX_AGENT __ATOMIC_RELAXED, __HIP_MEMORY_SCOPE_AGENT
#define LDS_WAIT() asm volatile("s_waitcnt lgkmcnt(0)" ::: "memory")
#define VM_WAIT() asm volatile("s_waitcnt vmcnt(0)" ::: "memory")
__device__ __forceinline__ unsigned long long rt() { return __builtin_amdgcn_s_memrealtime(); }
__device__ __forceinline__ unsigned f2bf(float f) { unsigned u = __builtin_bit_cast(unsigned, f); return (u + 0x7fffu + ((u >> 16) & 1u)) >> 16; }
__device__ __forceinline__ unsigned pk2(float lo, float hi) { return f2bf(lo) | (f2bf(hi) << 16); }

#define XB_TMO      128
#define XB_XCNT(j)  (256  + 64 * (j))
#define XB_XSUB(j)  (1280 + 64 * (j))
#define XB_XGEN(j)  (2304 + 64 * (j))
#define XB_TOP      3328
#define XB_TOPGEN   3392
#define XCD_BAR_WORDS 3456
#define XB_SPIN_CAP (1u << 18)

__device__ __forceinline__ unsigned xb_ld(unsigned* p)              { return __hip_atomic_load(p, __ATOMIC_RELAXED, __HIP_MEMORY_SCOPE_AGENT); }
__device__ __forceinline__ unsigned xb_add(unsigned* p, unsigned v) { return __hip_atomic_fetch_add(p, v, __ATOMIC_RELAXED, __HIP_MEMORY_SCOPE_AGENT); }
__device__ __forceinline__ unsigned xb_xcc_id() { return (unsigned)__builtin_amdgcn_s_getreg((3 << 11) | 20) & 0xFu; }
#define XB_SPIN(cond, bar) do { unsigned _sp = 0; while (cond) { __builtin_amdgcn_s_sleep(1); \
    if ((++_sp & 255u) == 0u) { if (xb_ld(&(bar)[XB_TMO])) break; if (_sp > XB_SPIN_CAP) { atomicAdd(&(bar)[XB_TMO], 1u); break; } } } } while (0)

struct XcdBarrier {
    unsigned* bar; unsigned x;
    volatile LAS unsigned* st;
};

__device__ __forceinline__ XcdBarrier xcd_barrier_post(unsigned* bar, volatile LAS unsigned* st) {
    XcdBarrier b; b.bar = bar; b.x = xb_xcc_id(); b.st = st;
    if (threadIdx.x == 0) (void)xb_add(&bar[XB_XCNT(b.x)], 1u);
    return b;
}
__device__ __forceinline__ void xcd_barrier_complete(unsigned* bar, unsigned x, unsigned& nloc, unsigned& nx) {
    const unsigned G = gridDim.x * gridDim.y * gridDim.z;
    unsigned sum, cnt, mine, sp = 0u;
    for (;;) {
        sum = 0u; cnt = 0u; mine = 0u;
#pragma unroll
        for (unsigned j = 0; j < 16; ++j) { const unsigned c = xb_ld(&bar[XB_XCNT(j)]); sum += c; cnt += (c > 0u) ? 1u : 0u; mine = (j == x) ? c : mine; }
        if (sum == G) break;
        __builtin_amdgcn_s_sleep(1);
        if ((++sp & 255u) == 0u) { if (xb_ld(&bar[XB_TMO])) break; if (sp > XB_SPIN_CAP) { atomicAdd(&bar[XB_TMO], 1u); break; } }
    }
    nloc = mine > 0u ? mine : 1u; nx = cnt > 0u ? cnt : 1u;
}

__device__ __forceinline__ void xcd_barrier(const XcdBarrier& b) {
    asm volatile("s_waitcnt vmcnt(0)" ::: "memory");
    __syncthreads();
    if (threadIdx.x == 0) {
        unsigned* bar = b.bar;
        __builtin_amdgcn_s_waitcnt(0);
        unsigned nloc = b.st[0], nx = b.st[1];
        if (nloc == 0u) { xcd_barrier_complete(bar, b.x, nloc, nx); b.st[0] = nloc; b.st[1] = nx; }
        const unsigned old = xb_add(&bar[XB_XSUB(b.x)], 1u);
        const unsigned gen = old / nloc;
        if (old + 1u == (gen + 1u) * nloc) {
            __builtin_amdgcn_fence(__ATOMIC_RELEASE, "agent");
            asm volatile("s_waitcnt vmcnt(0)" ::: "memory");
            const unsigned og = xb_add(&bar[XB_TOP], 1u);
            const unsigned tg = og / nx;
            if (og + 1u == (tg + 1u) * nx) xb_add(&bar[XB_TOPGEN], 1u);
            else XB_SPIN(xb_ld(&bar[XB_TOPGEN]) == tg, bar);
            __builtin_amdgcn_fence(__ATOMIC_ACQUIRE, "agent");
            xb_add(&bar[XB_XGEN(b.x)], 1u);
            asm volatile("s_waitcnt vmcnt(0)" ::: "memory");
        } else {
            XB_SPIN(xb_ld(&bar[XB_XGEN(b.x)]) == gen, bar);
            __builtin_amdgcn_fence(__ATOMIC_ACQUIRE, "agent");
            asm volatile("s_waitcnt vmcnt(0)" ::: "memory");
        }
    }
    __syncthreads();
}

typedef float f32x2g __attribute__((ext_vector_type(2)));
typedef unsigned u32x2g __attribute__((ext_vector_type(2)));
struct Frame {
    LAS unsigned char* lds;
    volatile LAS unsigned* MISC;
    gu32* ctl;
    int wave;
    int vcu, G;
    unsigned char* ws; float* out;

};
__device__ __forceinline__ float wave_sum(float v) {
#pragma unroll
    for (int o = 1; o < 64; o <<= 1) v += __shfl_xor(v, o);
    return v;
}
__device__ __forceinline__ float sigmoidf_(float x) { return __builtin_amdgcn_rcpf(1.f + __builtin_amdgcn_exp2f(-1.4426950408889634f * x)); }
__device__ __forceinline__ float gelu_tanh_(float x) { const float u = 1.5957691216057308f * (x + 0.044715f * x * x * x); return x * __builtin_amdgcn_rcpf(1.f + __builtin_amdgcn_exp2f(-1.4426950408889634f * u)); }
__device__ __forceinline__ float bf2f(unsigned short h) { return __builtin_bit_cast(float, (unsigned)h << 16); }

struct EpiIn {
    static constexpr bool PERM = true, AFTER_DRAIN = false;
    float* XL; bf16* GG; bf16* Q; bf16* K; bf16* V; float* kout; float* vout; const float* rope;
    __device__ __forceinline__ void operator()(const pg8::f32x4 (&acc)[2][2][4][2], const pg8::Unit& u, int wr, int wc, int fr, int fq) const {
        const int sec = u.pn >> 1;
        const int row0 = u.pm * 256 + wr * 64 + fr;
        const int cbase = (u.pn & 1) * 256 + wc * 32 + 8 * fq;
#pragma unroll
        for (int ai = 0; ai < 2; ++ai)
#pragma unroll
            for (int m = 0; m < 4; ++m) {
                const int row = row0 + ai * 128 + m * 16;
                f32x4 rc0, rc1, rs0, rs1;
                if ((sec == 2 || sec == 3) && !(wc & 1)) { const f32x4* rp = (const f32x4*)(rope + (size_t)(row & (TSEQ - 1)) * 16); rc0 = rp[0]; rc1 = rp[1]; rs0 = rp[2]; rs1 = rp[3]; }
#pragma unroll
                for (int bj = 0; bj < 2; ++bj) {
                    const int cs = cbase + bj * 128;
                    f32x4 v0 = acc[ai][bj][m][0], v1 = acc[ai][bj][m][1];
                    const size_t o = (size_t)row * 512 + cs;
                    if (sec == 0) { *(f32x4*)(XL + o) = v0; *(f32x4*)(XL + o + 4) = v1; }
                    else if (sec == 1) {
                        v4u w; w.x = pk2(gelu_tanh_(v0[0]), gelu_tanh_(v0[1])); w.y = pk2(gelu_tanh_(v0[2]), gelu_tanh_(v0[3])); w.z = pk2(gelu_tanh_(v1[0]), gelu_tanh_(v1[1])); w.w = pk2(gelu_tanh_(v1[2]), gelu_tanh_(v1[3]));
                        *(v4u*)(GG + o) = w; }
                    else {
                        if (sec != 4 && !(wc & 1)) {
                            f32x4 p0, p1;
#pragma unroll
                            for (int e = 0; e < 4; ++e) { p0[e] = __shfl_xor(v0[e], 16); p1[e] = __shfl_xor(v1[e], 16); }
                            if (fq == 0) { v0 = v0 * rc0 - p0 * rs0; v1 = v1 * rc1 - p1 * rs1; }
                            else if (fq == 1) { v0 = v0 * rc0 + p0 * rs0; v1 = v1 * rc1 + p1 * rs1; }
                        }
                        if (sec == 2) { v0 = v0 * C2; v1 = v1 * C2; v4u w; w.x = pk2(v0[0], v0[1]); w.y = pk2(v0[2], v0[3]); w.z = pk2(v1[0], v1[1]); w.w = pk2(v1[2], v1[3]); *(v4u*)(Q + o) = w; }
                        else { float* fo = (sec == 3 ? kout : vout) + o; *(f32x4*)fo = v0; *(f32x4*)(fo + 4) = v1;
                            v4u w; w.x = pk2(v0[0], v0[1]); w.y = pk2(v0[2], v0[3]); w.z = pk2(v1[0], v1[1]); w.w = pk2(v1[2], v1[3]); *(v4u*)((sec == 3 ? K : V) + o) = w; }
                    }
                }
            }
    }
};
struct EpiBf {
    static constexpr bool PERM = true, AFTER_DRAIN = false;
    bf16* O; int ldc;
    __device__ __forceinline__ void operator()(const pg8::f32x4 (&acc)[2][2][4][2], const pg8::Unit& u, int wr, int wc, int fr, int fq) const {
        const int row0 = u.pm * 256 + wr * 64 + fr, col0 = u.pn * 256 + wc * 32 + 8 * fq;
#pragma unroll
        for (int ai = 0; ai < 2; ++ai)
#pragma unroll
            for (int m = 0; m < 4; ++m)
#pragma unroll
                for (int bj = 0; bj < 2; ++bj) { const f32x4 v0 = acc[ai][bj][m][0], v1 = acc[ai][bj][m][1];
                    v4u w; w.x = pk2(v0[0], v0[1]); w.y = pk2(v0[2], v0[3]); w.z = pk2(v1[0], v1[1]); w.w = pk2(v1[2], v1[3]);
                    *(v4u*)(O + (size_t)(row0 + ai * 128 + m * 16) * ldc + col0 + bj * 128) = w; }
    }
};
struct EpiF32 {
    static constexpr bool PERM = true, AFTER_DRAIN = false;
    float* O; int ldc;
    __device__ __forceinline__ void operator()(const pg8::f32x4 (&acc)[2][2][4][2], const pg8::Unit& u, int wr, int wc, int fr, int fq) const {
        const int row0 = u.pm * 256 + wr * 64 + fr, col0 = u.pn * 256 + wc * 32 + 8 * fq;
#pragma unroll
        for (int ai = 0; ai < 2; ++ai)
#pragma unroll
            for (int m = 0; m < 4; ++m)
#pragma unroll
                for (int bj = 0; bj < 2; ++bj) { float* p = O + (size_t)(row0 + ai * 128 + m * 16) * ldc + col0 + bj * 128; *(f32x4*)p = acc[ai][bj][m][0]; *(f32x4*)(p + 4) = acc[ai][bj][m][1]; }
    }
};
struct EpiSwiGlu {
    static constexpr bool PERM = true, AFTER_DRAIN = false;
    bf16* H;
    __device__ __forceinline__ void operator()(const pg8::f32x4 (&acc)[2][2][4][2], const pg8::Unit& u, int wr, int wc, int fr, int fq) const {
        const int row0 = u.pm * 256 + wr * 64 + fr, col0 = u.pn * 128 + wc * 32 + 8 * fq;
#pragma unroll
        for (int ai = 0; ai < 2; ++ai)
#pragma unroll
            for (int m = 0; m < 4; ++m) { const f32x4 g0 = acc[ai][0][m][0], g1 = acc[ai][0][m][1], u0 = acc[ai][1][m][0], u1 = acc[ai][1][m][1]; float h[8];
#pragma unroll
                for (int e = 0; e < 4; ++e) { h[e] = g0[e] * sigmoidf_(g0[e]) * u0[e]; h[4 + e] = g1[e] * sigmoidf_(g1[e]) * u1[e]; }
                v4u w; w.x = pk2(h[0], h[1]); w.y = pk2(h[2], h[3]); w.z = pk2(h[4], h[5]); w.w = pk2(h[6], h[7]);
                *(v4u*)(H + (size_t)(row0 + ai * 128 + m * 16) * FF + col0) = w; }
    }
};
struct EpiPle {
    static constexpr bool PERM = true, AFTER_DRAIN = false;
    const bf16* P; float* O;
    __device__ __forceinline__ void operator()(const pg8::f32x4 (&acc)[2][2][4][2], const pg8::Unit& u, int wr, int wc, int fr, int fq) const {
        const int row0 = u.pm * 256 + wr * 64 + fr, col0 = u.pn * 256 + wc * 32 + 8 * fq;
#pragma unroll
        for (int ai = 0; ai < 2; ++ai)
#pragma unroll
            for (int m = 0; m < 4; ++m)
#pragma unroll
                for (int bj = 0; bj < 2; ++bj) { const size_t o = (size_t)(row0 + ai * 128 + m * 16) * DM + col0 + bj * 128; const v4u pw = *(const v4u*)(P + o);
                    const f32x4 v0 = acc[ai][bj][m][0], v1 = acc[ai][bj][m][1]; f32x4 r0, r1;
                    r0[0] = sigmoidf_(v0[0]) * bf2f((unsigned short)(pw.x & 0xffff)); r0[1] = sigmoidf_(v0[1]) * bf2f((unsigned short)(pw.x >> 16));
                    r0[2] = sigmoidf_(v0[2]) * bf2f((unsigned short)(pw.y & 0xffff)); r0[3] = sigmoidf_(v0[3]) * bf2f((unsigned short)(pw.y >> 16));
                    r1[0] = sigmoidf_(v1[0]) * bf2f((unsigned short)(pw.z & 0xffff)); r1[1] = sigmoidf_(v1[1]) * bf2f((unsigned short)(pw.z >> 16));
                    r1[2] = sigmoidf_(v1[2]) * bf2f((unsigned short)(pw.w & 0xffff)); r1[3] = sigmoidf_(v1[3]) * bf2f((unsigned short)(pw.w >> 16));
                    *(f32x4*)(O + o) = r0; *(f32x4*)(O + o + 4) = r1; }
    }
};

template <int AMODE> __device__ __forceinline__ bf16x8 sg_load_a(const void* A, int lda, int row, int k) {
    if constexpr (AMODE == 0) { return *(const bf16x8*)((const bf16*)A + (size_t)row * lda + k); }
    else { const float* g = (const float*)A + (size_t)row * GU + (k >> 7) * 256 + (k & 127); const f32x4 g0 = *(const f32x4*)g, g1 = *(const f32x4*)(g + 4), u0 = *(const f32x4*)(g + 128), u1 = *(const f32x4*)(g + 132);
        v4u w; w.x = pk2(g0[0] * sigmoidf_(g0[0]) * u0[0], g0[1] * sigmoidf_(g0[1]) * u0[1]); w.y = pk2(g0[2] * sigmoidf_(g0[2]) * u0[2], g0[3] * sigmoidf_(g0[3]) * u0[3]);
        w.z = pk2(g1[0] * sigmoidf_(g1[0]) * u1[0], g1[1] * sigmoidf_(g1[1]) * u1[1]); w.w = pk2(g1[2] * sigmoidf_(g1[2]) * u1[2], g1[3] * sigmoidf_(g1[3]) * u1[3]);
        return __builtin_bit_cast(bf16x8, w); }
}
template <int AMODE> __device__ __forceinline__ void small_gemm(Frame& F, const void* A, int lda, const bf16* Bt, int N, int K, float* C, int ldc) {
    LAS float* part = (LAS float*)(F.lds + RING_OFF);
    const int lane = lane_now(), tid = F.wave * 64 + lane, w = F.wave, fr = lane & 15, fq = lane >> 4;
    const int nitems = 8 * (N / 32), kw = K / 8;
    for (int it = F.G - 1 - (int)blockIdx.x; it < nitems; it += F.G) {
        const int row0 = (it & 7) * 16, col0 = (it >> 3) * 32;
        f32x4 acc0 = {0.f, 0.f, 0.f, 0.f}, acc1 = {0.f, 0.f, 0.f, 0.f};
        const int kbeg = w * kw;
        const bf16* b0p = Bt + (size_t)(col0 + fr) * K + 8 * fq; const bf16* b1p = b0p + (size_t)16 * K;
#pragma unroll 4
        for (int k = kbeg; k < kbeg + kw; k += 32) {
            const bf16x8 a = sg_load_a<AMODE>(A, lda, row0 + fr, k + 8 * fq);
            const bf16x8 b0 = *(const bf16x8*)(b0p + k), b1 = *(const bf16x8*)(b1p + k);
            acc0 = __builtin_amdgcn_mfma_f32_16x16x32_bf16(a, b0, acc0, 0, 0, 0);
            acc1 = __builtin_amdgcn_mfma_f32_16x16x32_bf16(a, b1, acc1, 0, 0, 0);
        }
#pragma unroll
        for (int r = 0; r < 4; ++r) { part[((w * 2 + 0) * 4 + r) * 64 + lane] = acc0[r]; part[((w * 2 + 1) * 4 + r) * 64 + lane] = acc1[r]; }
        __syncthreads();
        { const int r = tid >> 5, n = tid & 31, c = n >> 4, ln = (n & 15) + 16 * (r >> 2), rg = r & 3; float s = 0.f;
#pragma unroll
          for (int w2 = 0; w2 < 8; ++w2) s += part[((w2 * 2 + c) * 4 + rg) * 64 + ln];
          C[(size_t)(row0 + r) * ldc + col0 + n] = s; }
        __syncthreads();
    }
}

__device__ __forceinline__ void p0_transpose_item(const float* W, int N, bf16* WT, int ldt, int k0, int n0, int dst_row, LAS float* scr, int lane) {
#pragma unroll 8
    for (int i = 0; i < 32; ++i) { const int kk = 2 * i + (lane >> 5); scr[kk * 33 + (lane & 31)] = W[(size_t)(k0 + kk) * N + n0 + (lane & 31)]; }
    LDS_WAIT(); asm volatile("" ::: "memory");
    const int c = lane & 7;
#pragma unroll
    for (int j = 0; j < 4; ++j) { const int n = (lane >> 3) + 8 * j; const LAS float* s = scr + (8 * c) * 33 + n;
        v4u o; o.x = pk2(s[0 * 33], s[1 * 33]); o.y = pk2(s[2 * 33], s[3 * 33]); o.z = pk2(s[4 * 33], s[5 * 33]); o.w = pk2(s[6 * 33], s[7 * 33]);
        *(GAS v4u*)(WT + (size_t)(dst_row + n) * ldt + k0 + 8 * c) = o; }
    LDS_WAIT(); asm volatile("" ::: "memory");
}
__device__ __forceinline__ void row_load(const float* xrow, int lane, f32x4 (&v)[4]) {
    const GAS f32x4* xr = (const GAS f32x4*)xrow + lane;
#pragma unroll
    for (int j = 0; j < 4; ++j) v[j] = xr[64 * j];
}
__device__ __forceinline__ float row_ssq(const f32x4 (&v)[4]) { float s = 0.f;
#pragma unroll
    for (int j = 0; j < 4; ++j) s += (v[j].x * v[j].x + v[j].y * v[j].y) + (v[j].z * v[j].z + v[j].w * v[j].w);
    return wave_sum(s); }
__device__ __forceinline__ void row_store_bf16(bf16* orow, int lane, const f32x4 (&v)[4]) {
    GAS unsigned long long* o8 = (GAS unsigned long long*)orow + lane;
#pragma unroll
    for (int j = 0; j < 4; ++j) o8[64 * j] = (unsigned long long)pk2(v[j].x, v[j].y) | ((unsigned long long)pk2(v[j].z, v[j].w) << 32);
}
__device__ __forceinline__ void row_store_f32(float* orow, int lane, const f32x4 (&v)[4]) {
    GAS f32x4* o = (GAS f32x4*)orow + lane;
#pragma unroll
    for (int j = 0; j < 4; ++j) o[64 * j] = v[j];
}

struct LruArgs {
    const float* XL; const float* conv_w; const float* conv_b; const bf16* WL; const float* ba; const float* bx; const float* Lp;
    float* HL; float* PC; float* CHS;
    const float* US; const float* sconv; const float* sh; float* hout; bf16* amix;
};
template <bool SAMPLE> __device__ __forceinline__ void lru_unit(Frame& F, const LruArgs& A, int unit) {
    const int lane = lane_now(), n = F.wave, i16 = lane & 15, kq = lane >> 4;
    LAS float* XC = (LAS float*)(F.lds + RING_OFF) + n * (3 * 16 * 65);
    LAS float* RR = XC + 16 * 65; LAS float* IG = RR + 16 * 65;
    bf16x8 bR[4][2], bI[4][2];
#pragma unroll
    for (int nt = 0; nt < 4; ++nt)
#pragma unroll
        for (int ks = 0; ks < 2; ++ks) { const size_t o = (size_t)n * 4096 + (size_t)(16 * nt + i16) * 64 + 32 * ks + 8 * kq; bR[nt][ks] = *(const bf16x8*)(A.WL + o); bI[nt][ks] = *(const bf16x8*)(A.WL + 32768 + o); }
    float bar_[4], bxr_[4];
#pragma unroll
    for (int nt = 0; nt < 4; ++nt) { bar_[nt] = A.ba[64 * n + 16 * nt + i16]; bxr_[nt] = A.bx[64 * n + 16 * nt + i16]; }
    const int chl = 64 * n + lane;
    const float sp = log1pf(expf(-A.Lp[chl]));
    float hl = 0.f, pc = 1.f;
    const int r0 = unit * 64;
    const int t0 = SAMPLE ? 0 : (r0 & (TSEQ - 1));
    for (int mt = 0; mt < 4; ++mt) {
        const int rl = 16 * mt + i16;
        bf16x8 afr[2];
#pragma unroll
        for (int ks = 0; ks < 2; ++ks) {
            const int c0 = 64 * n + 32 * ks + 8 * kq;
            float xc[8];
#pragma unroll
            for (int e = 0; e < 8; ++e) xc[e] = A.conv_b[c0 + e];
#pragma unroll
            for (int tap = 0; tap < 4; ++tap) {
                f32x4 x0, x1;
                if (SAMPLE) { const int b = r0 + rl; const float* p = (tap == 3) ? A.US + (size_t)b * INW + c0 : A.sconv + ((size_t)b * 3 + tap) * LW + c0; x0 = *(const f32x4*)p; x1 = *(const f32x4*)(p + 4); }
                else { const int back = 3 - tap; if (t0 + rl - back >= 0) { const float* p = A.XL + (size_t)(r0 + rl - back) * LW + c0; x0 = *(const f32x4*)p; x1 = *(const f32x4*)(p + 4); } else { x0 = (f32x4){0.f, 0.f, 0.f, 0.f}; x1 = x0; } }
                const f32x4 w0 = *(const f32x4*)(A.conv_w + tap * LW + c0), w1 = *(const f32x4*)(A.conv_w + tap * LW + c0 + 4);
#pragma unroll
                for (int e = 0; e < 4; ++e) { xc[e] += x0[e] * w0[e]; xc[4 + e] += x1[e] * w1[e]; }
            }
#pragma unroll
            for (int e = 0; e < 8; ++e) XC[i16 * 65 + 32 * ks + 8 * kq + e] = xc[e];
            v4u w; w.x = pk2(xc[0], xc[1]); w.y = pk2(xc[2], xc[3]); w.z = pk2(xc[4], xc[5]); w.w = pk2(xc[6], xc[7]);
            afr[ks] = __builtin_bit_cast(bf16x8, w);
        }
#pragma unroll
        for (int nt = 0; nt < 4; ++nt) {
            f32x4 aR = {0.f, 0.f, 0.f, 0.f}, aI = {0.f, 0.f, 0.f, 0.f};
#pragma unroll
            for (int ks = 0; ks < 2; ++ks) { aR = __builtin_amdgcn_mfma_f32_16x16x32_bf16(afr[ks], bR[nt][ks], aR, 0, 0, 0); aI = __builtin_amdgcn_mfma_f32_16x16x32_bf16(afr[ks], bI[nt][ks], aI, 0, 0, 0); }
#pragma unroll
            for (int r = 0; r < 4; ++r) { RR[(4 * kq + r) * 65 + 16 * nt + i16] = sigmoidf_(aR[r] + bar_[nt]); IG[(4 * kq + r) * 65 + 16 * nt + i16] = sigmoidf_(aI[r] + bxr_[nt]); }
        }
        LDS_WAIT(); asm volatile("" ::: "memory");
#pragma unroll 4
        for (int tl = 0; tl < 16; ++tl) {
            const float rr = RR[tl * 65 + lane], gg = IG[tl * 65 + lane], x = XC[tl * 65 + lane];
            const float la = -8.f * rr * sp, a = expf(la), bt = sqrtf(-expm1f(2.f * la)) * (gg * x);
            const int row = r0 + 16 * mt + tl;
            if (SAMPLE) { const float h = a * A.sh[(size_t)row * LW + chl] + bt; A.hout[(size_t)row * LW + chl] = h;
                const float g = A.US[(size_t)row * INW + LW + chl]; A.amix[(size_t)(MP + row) * DM + chl] = (bf16)f2bf(h * gelu_tanh_(g)); }
            else { hl = a * hl + bt; pc *= a; A.HL[(size_t)row * LW + chl] = hl; A.PC[(size_t)row * LW + chl] = pc; }
        }
        LDS_WAIT(); asm volatile("" ::: "memory");
    }
    if (!SAMPLE) { A.CHS[(size_t)unit * 2 * LW + chl] = pc; A.CHS[(size_t)unit * 2 * LW + LW + chl] = hl; }
}

struct DecArgs { const float* US; const float* rope; const float* ck; const float* cv; const int* pt; float* ksout; float* vsout; float* QS; float* DP; };
__device__ __forceinline__ float row16_sum(float v) {
    v += __shfl_xor(v, 1); v += __shfl_xor(v, 2); v += __shfl_xor(v, 4); v += __shfl_xor(v, 8); return v;
}
__device__ __forceinline__ void decode_unit(Frame& F, const DecArgs& A, int b, int split) {
    LAS float* qs = (LAS float*)(F.lds + RING_OFF);
    LAS float* racc = qs + 512;
    LAS float* rml = racc + 8 * 8 * 64;
    const int lane = lane_now();
    { const int cs = F.wave * 64 + lane, d = cs & 63; const float* ub = A.US + (size_t)b * INW;
      float qv = ub[1024 + cs], kv = ub[1536 + cs];
      if (d < 16) { const int i = d & 7, pc = d < 8 ? cs + 8 : cs - 8; const float c = A.rope[(size_t)PASTLEN * 16 + i], s = A.rope[(size_t)PASTLEN * 16 + 8 + i];
          const float qp = ub[1024 + pc], kp = ub[1536 + pc];
          if (d < 8) { qv = qv * c - qp * s; kv = kv * c - kp * s; } else { qv = qv * c + qp * s; kv = kv * c + kp * s; } }
      qs[cs] = qv * C2;
      if (split == 0) { A.QS[(size_t)b * AW + cs] = qv * C2; A.ksout[(size_t)b * AW + cs] = kv; A.vsout[(size_t)b * AW + cs] = ub[2048 + cs]; } }
    __syncthreads();
    const int w = F.wave, hp = w & 1, sub = w >> 1;
    const int head = 2 * hp + (lane >> 5), e4 = 4 * (lane & 31);
    const bool map0 = ((lane >> 4) & 1) == 0;
    const f32x4 q = *(const LAS f32x4*)(qs + head * 128 + e4);
    float m = -1e30f, l = 0.f; f32x4 a1 = {0.f, 0.f, 0.f, 0.f}, a2 = {0.f, 0.f, 0.f, 0.f};
    for (int pg = 0; pg < 2; ++pg) {
        const int page = __builtin_amdgcn_readfirstlane(A.pt[b * NPAGE + split * 8 + sub * 2 + pg]);
        const float* kb = A.ck + (size_t)page * (PAGE * 512) + head * 128 + e4;
        const float* vb = A.cv + (size_t)page * (PAGE * 512) + head * 128 + e4;
        for (int s0 = 0; s0 < PAGE; s0 += 8) {
            f32x4 kk[8], vv[8];
#pragma unroll
            for (int j = 0; j < 8; ++j) { kk[j] = __builtin_nontemporal_load((const f32x4*)(kb + (size_t)(s0 + j) * 512)); vv[j] = __builtin_nontemporal_load((const f32x4*)(vb + (size_t)(s0 + j) * 512)); }
            float sc[8]; float mx = -1e30f;
#pragma unroll
            for (int j = 0; j < 8; ++j) { sc[j] = row16_sum((q[0] * kk[j][0] + q[1] * kk[j][1]) + (q[2] * kk[j][2] + q[3] * kk[j][3])); mx = fmaxf(mx, sc[j]); }
            const float mn = fmaxf(m, mx), corr = __builtin_amdgcn_exp2f(m - mn); m = mn;
            float p[8], ps = 0.f;
#pragma unroll
            for (int j = 0; j < 8; ++j) { p[j] = __builtin_amdgcn_exp2f(sc[j] - mn); ps += p[j]; }
            l = l * corr + ps;
            const float corr_o = __shfl_xor(corr, 16);
            const float c1 = map0 ? corr : corr_o, c2 = map0 ? corr_o : corr;
            a1 = a1 * c1; a2 = a2 * c2;
#pragma unroll
            for (int j = 0; j < 8; ++j) { const float po = __shfl_xor(p[j], 16); const float p1 = map0 ? p[j] : po, p2 = map0 ? po : p[j]; a1 += vv[j] * p1; a2 += vv[j] * p2; }
        }
    }
#pragma unroll
    for (int e = 0; e < 4; ++e) { racc[(w * 8 + e) * 64 + lane] = a1[e]; racc[(w * 8 + 4 + e) * 64 + lane] = a2[e]; }
    rml[(w * 2 + 0) * 64 + lane] = m; rml[(w * 2 + 1) * 64 + lane] = l;
    __syncthreads();
    if (w < 2) {
        const int l1 = lane & ~16, l2 = lane | 16;
        float M1 = -1e30f, M2 = -1e30f;
#pragma unroll
        for (int s = 0; s < 4; ++s) { const int wv = hp + 2 * s; M1 = fmaxf(M1, rml[(wv * 2) * 64 + l1]); M2 = fmaxf(M2, rml[(wv * 2) * 64 + l2]); }
        float L1 = 0.f, L2 = 0.f; f32x4 o1 = {0.f, 0.f, 0.f, 0.f}, o2 = {0.f, 0.f, 0.f, 0.f};
#pragma unroll
        for (int s = 0; s < 4; ++s) { const int wv = hp + 2 * s;
            const float w1 = __builtin_amdgcn_exp2f(rml[(wv * 2) * 64 + l1] - M1), w2 = __builtin_amdgcn_exp2f(rml[(wv * 2) * 64 + l2] - M2);
            L1 += rml[(wv * 2 + 1) * 64 + l1] * w1; L2 += rml[(wv * 2 + 1) * 64 + l2] * w2;
#pragma unroll
            for (int e = 0; e < 4; ++e) { o1[e] += racc[(wv * 8 + e) * 64 + lane] * w1; o2[e] += racc[(wv * 8 + 4 + e) * 64 + lane] * w2; } }
        float* dp = A.DP + ((size_t)(b * 2 + split) * 4 + head) * DP_STRIDE;
        *(f32x4*)(dp + e4) = o1; *(f32x4*)(dp + 132 + e4) = o2;
        if ((lane & 31) == 0) { dp[128] = M1; dp[129] = L1; dp[132 + 128] = M2; dp[132 + 129] = L2; }
    }
    __syncthreads();
}


#ifndef MK_N_LAUNCHES
#define MK_N_LAUNCHES 1
#endif
constexpr int N_PHASES = 11;
struct Args { const void* in[33]; float* out; unsigned char* ws; float inv_freq[8]; int ph_lo, ph_hi, li, pad; };
enum { I_XP = 0, I_XS, I_CK, I_CV, I_SCONV, I_SH, I_PT, I_PP, I_PS, I_NPM, I_WIN, I_CONVW, I_CONVB, I_WA, I_BA, I_WX, I_BX, I_L, I_LQ1, I_LK1, I_LQ2, I_LK2, I_SUBG, I_WOUT, I_NPOSTM, I_NPREF,
       I_WG, I_WU, I_WD, I_NPOSTF, I_PWG, I_PWP, I_PNORM };

__global__ void __launch_bounds__(NWAVES * 64, 2) hymba_fwd(Args args) {
    extern __shared__ __attribute__((aligned(16))) unsigned char lds[];
    Frame F;
    F.lds = (LAS unsigned char*)lds;
    F.MISC = (volatile LAS unsigned*)(F.lds + MISC_OFF);
    F.wave = __builtin_amdgcn_readfirstlane((int)threadIdx.x >> 6);
    F.G = gridDim.x; { const int bx = blockIdx.x; F.vcu = (F.G % 8 == 0) ? (bx % 8) * (F.G / 8) + bx / 8 : bx; }
    F.ctl = (gu32*)(args.ws + WS_CTL);
#define INF(k) ((const float*)args.in[k])
#define WSB(off) ((bf16*)(args.ws + (off)))
#define WSF(off) ((float*)(args.ws + (off)))
#define WIN WSB(WS_WIN)
#define WOUT WSB(WS_WOUT)
#define WGU WSB(WS_WGU)
#define WD WSB(WS_WD)
#define WPG WSB(WS_WPG)
#define WPP WSB(WS_WPP)
#define WLRU WSB(WS_WLRU)
#define ROPE WSF(WS_ROPE)
#define XN WSB(WS_XN)
#define PB WSB(WS_PB)
#define XL WSF(WS_XL)
#define GG WSB(WS_GG)
#define QB_ WSB(WS_Q)
#define KB_ WSB(WS_K)
#define VB_ WSB(WS_V)
#define OB WSB(WS_O)
#define HL WSF(WS_HL)
#define PC WSF(WS_PC)
#define CHS WSF(WS_CHS)
#define AMIX WSB(WS_AMIX)
#define MIX WSF(WS_MIX)
#define X1 WSF(WS_X1)
#define HB WSB(WS_HB)
#define PROJ WSB(WS_PROJ)
#define US WSF(WS_US)
#define GUS WSF(WS_GUS)
#define GS WSF(WS_GS)
#define PJS WSF(WS_PJS)
#define QS WSF(WS_QS)
#define DP WSF(WS_DP)
    for (int u = threadIdx.x; u < (LDS_BYTES - LDSCTL_OFF) / 4; u += NWAVES * 64) ((LAS unsigned*)(F.lds + LDSCTL_OFF))[u] = 0u;
    __syncthreads();
    XcdBarrier bar; bar.bar = (unsigned*)(F.ctl + CW_BAR) + args.li * XCD_BAR_WORDS; bar.x = 0; bar.st = nullptr;
    if (args.ph_hi - args.ph_lo > 1) bar = xcd_barrier_post((unsigned*)(F.ctl + CW_BAR) + args.li * XCD_BAR_WORDS, F.MISC + 8);
    const int lo = args.ph_lo, hi = args.ph_hi;
#define IN(k) (lo <= (k) && (k) < hi)
#define BOTH(k) (IN(k) && IN((k) + 1))
#define GRID_BAR() xcd_barrier(bar)
    const int gw = F.vcu * NWAVES + F.wave, NGW = F.G * NWAVES;

    if (IN(0)) {
        const int lane = lane_now(), tid = F.wave * 64 + lane; (void)tid;
        LAS float* scr = (LAS float*)(F.lds + RING_OFF + F.wave * 16384);
        constexpr int I_IN = (DM / 64) * (INW / 32), I_SQ = (DM / 64) * (DM / 32), I_G = (DM / 64) * (FF / 32), I_D = (FF / 64) * (DM / 32), I_P = (PLE / 64) * (DM / 32), I_LR = 8 * 2;
        constexpr int NITEMS = I_IN + I_SQ + 2 * I_G + I_D + I_SQ + I_P + 2 * I_LR;
        for (int it = gw; it < NITEMS; it += NGW) {
            int r = it;
            if (r < I_IN) { const int nb = INW / 32, kb = r / nb, n0 = 32 * (r % nb); p0_transpose_item(INF(I_WIN), INW, WIN, DM, 64 * kb, n0, n0, scr, lane); continue; } r -= I_IN;
            if (r < I_SQ) { const int nb = DM / 32, kb = r / nb, n0 = 32 * (r % nb); p0_transpose_item(INF(I_WOUT), DM, WOUT, DM, 64 * kb, n0, n0, scr, lane); continue; } r -= I_SQ;
            if (r < I_G) { const int nb = FF / 32, kb = r / nb, n0 = 32 * (r % nb); p0_transpose_item(INF(I_WG), FF, WGU, DM, 64 * kb, n0, 256 * (n0 >> 7) + (n0 & 127), scr, lane); continue; } r -= I_G;
            if (r < I_G) { const int nb = FF / 32, kb = r / nb, n0 = 32 * (r % nb); p0_transpose_item(INF(I_WU), FF, WGU, DM, 64 * kb, n0, 256 * (n0 >> 7) + 128 + (n0 & 127), scr, lane); continue; } r -= I_G;
            if (r < I_D) { const int nb = DM / 32, kb = r / nb, n0 = 32 * (r % nb); p0_transpose_item(INF(I_WD), DM, WD, FF, 64 * kb, n0, n0, scr, lane); continue; } r -= I_D;
            if (r < I_SQ) { const int nb = DM / 32, kb = r / nb, n0 = 32 * (r % nb); p0_transpose_item(INF(I_PWG), DM, WPG, DM, 64 * kb, n0, n0, scr, lane); continue; } r -= I_SQ;
            if (r < I_P) { const int nb = DM / 32, kb = r / nb, n0 = 32 * (r % nb); p0_transpose_item(INF(I_PWP), DM, WPP, PLE, 64 * kb, n0, n0, scr, lane); continue; } r -= I_P;
            if (r < I_LR) { const int blk = r >> 1, n0 = 32 * (r & 1); p0_transpose_item(INF(I_WA) + blk * 4096, 64, WLRU + blk * 4096, 64, 0, n0, n0, scr, lane); continue; } r -= I_LR;
            { const int blk = r >> 1, n0 = 32 * (r & 1); p0_transpose_item(INF(I_WX) + blk * 4096, 64, WLRU + 32768 + blk * 4096, 64, 0, n0, n0, scr, lane); }
        }
        for (int i = blockIdx.x * (NWAVES * 64) + tid; i < TSEQ * 8; i += F.G * NWAVES * 64) { const int pos = i >> 3, k = i & 7; const float ang = (float)pos * args.inv_freq[k];
            const double ad = (double)ang, nn = rint(ad * 0.15915494309189535); const float rf = (float)(ad - nn * 6.283185307179586);
            ROPE[(size_t)pos * 16 + k] = cosf(rf); ROPE[(size_t)pos * 16 + 8 + k] = sinf(rf); }
        { f32x4 g[4]; row_load(INF(I_NPM), lane, g);
          for (int m = gw; m < MTOT; m += NGW) { const float* xr = m < MP ? INF(I_XP) + (size_t)m * DM : INF(I_XS) + (size_t)(m - MP) * DM; f32x4 v[4]; row_load(xr, lane, v);
              const float rstd = 1.f / sqrtf(row_ssq(v) * (1.f / DM) + 1e-6f);
#pragma unroll
              for (int j = 0; j < 4; ++j) v[j] = v[j] * rstd * g[j];
              row_store_bf16(XN + (size_t)m * DM, lane, v); } }
        for (int m = gw; m < MTOT; m += NGW) { const float* pr = m < MP ? INF(I_PP) + (size_t)m * PLE : INF(I_PS) + (size_t)(m - MP) * PLE; const f32x4 v = ((const GAS f32x4*)pr)[lane];
            ((GAS unsigned long long*)(PB + (size_t)m * PLE))[lane] = (unsigned long long)pk2(v.x, v.y) | ((unsigned long long)pk2(v.z, v.w) << 32); }
        if (BOTH(0)) GRID_BAR();
    }

    if (IN(1)) {
        const int lane = lane_now(), tid = F.wave * 64 + lane; (void)tid;
        { pg8::Gemm g{XN, WIN, MP, INW, DM}; pg8::StaticOrder S; S.init(MP, INW, F.G, (int)blockIdx.x);
          EpiIn E{XL, GG, QB_, KB_, VB_, args.out + OK_P, args.out + OV_P, ROPE};
          pg8::gemm_phase<EpiIn, pg8::StaticOrder, true, true>(F.lds + RING_OFF, g, S, E); }
        { const int half = F.G / 2;
          if ((int)blockIdx.x >= half) { pg8::Gemm g{PB, WPP, MP, DM, PLE}; pg8::StaticOrder S; S.init(MP, DM, F.G - half, (int)blockIdx.x - half);
              EpiBf E{PROJ, DM};
              pg8::gemm_phase<EpiBf, pg8::StaticOrder, true, true>(F.lds + RING_OFF, g, S, E); } }
        __syncthreads();
        small_gemm<0>(F, XN + (size_t)MP * DM, DM, WIN, INW, DM, US, INW);
        small_gemm<0>(F, PB + (size_t)MP * PLE, PLE, WPP, DM, PLE, PJS, DM);
        if (BOTH(1)) GRID_BAR();
    }

    if (IN(2)) {
        const int lane = lane_now(), tid = F.wave * 64 + lane; (void)tid;
        LruArgs LA{XL, INF(I_CONVW), INF(I_CONVB), WLRU, INF(I_BA), INF(I_BX), INF(I_L), HL, PC, CHS, US, INF(I_SCONV), INF(I_SH), args.out + OH_S, AMIX};
        for (int c = (int)blockIdx.x; c < NCHUNK; c += F.G) lru_unit<false>(F, LA, c);
        for (int c = F.G - 1 - (int)blockIdx.x; c < MS / 64; c += F.G) lru_unit<true>(F, LA, c);
        for (int i = blockIdx.x * (NWAVES * 64) + tid; i < MS * 3 * LW; i += F.G * NWAVES * 64) { const int b = i / (3 * LW), r = (i / LW) % 3, ch = i % LW;
            args.out[OC_S + i] = r < 2 ? INF(I_SCONV)[((size_t)b * 3 + r + 1) * LW + ch] : US[(size_t)b * INW + ch]; }
        for (int i = blockIdx.x * (NWAVES * 64) + tid; i < NBATCH * 3 * LW; i += F.G * NWAVES * 64) { const int b = i / (3 * LW), r = (i / LW) % 3, ch = i % LW;
            args.out[OC_P + i] = XL[((size_t)b * TSEQ + TSEQ - 3 + r) * LW + ch]; }
        __syncthreads();
        { const attn_body::AttnTensors AT{(const attn_body::bf16*)QB_, (const attn_body::bf16*)KB_, (const attn_body::bf16*)VB_, (attn_body::bf16*)OB};
          const attn_body::StaticOrder S((int)F.G, (int)blockIdx.x);
          attn_body::attn_phase<attn_body::StaticOrder>((char*)lds + RING_OFF, AT, S); }
        __syncthreads();
        { DecArgs DA{US, ROPE, INF(I_CK), INF(I_CV), (const int*)args.in[I_PT], args.out + OK_S, args.out + OV_S, QS, DP};
          for (int u = (int)blockIdx.x; u < MS * 2; u += F.G) decode_unit(F, DA, u >> 1, u & 1); }
        if (BOTH(2)) GRID_BAR();
    }

    if (IN(3)) {
        const int lane = lane_now(), tid = F.wave * 64 + lane; (void)tid;
        const float lam = expf(wave_sum(INF(I_LQ1)[lane] * INF(I_LK1)[lane])) - expf(wave_sum(INF(I_LQ2)[lane] * INF(I_LK2)[lane])) + LAM_INIT;
        for (int c = (int)blockIdx.x; c < NCHUNK; c += F.G) {
            const int ch = tid, cb = c & ~(TSEQ / CHUNK - 1);
            float carry = 0.f;
            for (int cc = cb; cc < c; ++cc) carry = CHS[(size_t)cc * 2 * LW + ch] * carry + CHS[(size_t)cc * 2 * LW + LW + ch];
            float h = 0.f;
            for (int r = 0; r < CHUNK; ++r) { const size_t o = (size_t)(c * CHUNK + r) * LW + ch; h = HL[o] + PC[o] * carry; AMIX[(size_t)(c * CHUNK + r) * DM + ch] = (bf16)f2bf(h * bf2f(GG[o])); }
            if ((c & (TSEQ / CHUNK - 1)) == TSEQ / CHUNK - 1) args.out[OH_P + (size_t)(c / (TSEQ / CHUNK)) * LW + ch] = h;
            for (int rr = 0; rr < 8; ++rr) { const int row = c * CHUNK + F.wave * 8 + rr;
                const v4u w1 = *(const v4u*)(OB + (size_t)row * 1024 + 8 * lane), w2 = *(const v4u*)(OB + (size_t)row * 1024 + 512 + 8 * lane);
                float o[8]; const unsigned a1[4] = {w1.x, w1.y, w1.z, w1.w}, a2[4] = {w2.x, w2.y, w2.z, w2.w};
#pragma unroll
                for (int e = 0; e < 4; ++e) { o[2 * e] = bf2f((unsigned short)(a1[e] & 0xffff)) - lam * bf2f((unsigned short)(a2[e] & 0xffff)); o[2 * e + 1] = bf2f((unsigned short)(a1[e] >> 16)) - lam * bf2f((unsigned short)(a2[e] >> 16)); }
                float ss = 0.f;
#pragma unroll
                for (int e = 0; e < 8; ++e) ss += o[e] * o[e];
                ss = row16_sum(ss);
                const float rstd = SUBLN_SCALE / sqrtf(ss * (1.f / 128.f) + 1e-5f);
                const float* gp = INF(I_SUBG) + 8 * (lane & 15); const f32x4 g0 = *(const f32x4*)gp, g1 = *(const f32x4*)(gp + 4);
                v4u w; w.x = pk2(o[0] * rstd * g0[0], o[1] * rstd * g0[1]); w.y = pk2(o[2] * rstd * g0[2], o[3] * rstd * g0[3]); w.z = pk2(o[4] * rstd * g1[0], o[5] * rstd * g1[1]); w.w = pk2(o[6] * rstd * g1[2], o[7] * rstd * g1[3]);
                *(v4u*)(AMIX + (size_t)row * DM + 512 + 8 * lane) = w; }
        }
        for (int it = gw; it < MS * 4; it += NGW) { const int b = it >> 2, head = it & 3;
            const float* q = QS + (size_t)b * AW + head * 128; const float* kn = args.out + OK_S + (size_t)b * AW + head * 128; const float* vn = args.out + OV_S + (size_t)b * AW + head * 128;
            const float s1n = wave_sum(q[lane] * kn[lane]), s2n = wave_sum(q[64 + lane] * kn[64 + lane]);
            const float* d0 = DP + ((size_t)(b * 2 + 0) * 4 + head) * DP_STRIDE; const float* d1 = DP + ((size_t)(b * 2 + 1) * 4 + head) * DP_STRIDE;
            float om[2][2];
#pragma unroll
            for (int mp = 0; mp < 2; ++mp) { const float* e0 = d0 + mp * 132; const float* e1 = d1 + mp * 132; const float sn = mp ? s2n : s1n;
                const float M = fmaxf(fmaxf(e0[128], e1[128]), sn); const float wa = __builtin_amdgcn_exp2f(e0[128] - M), wb = __builtin_amdgcn_exp2f(e1[128] - M), wn = __builtin_amdgcn_exp2f(sn - M);
                const float L = e0[129] * wa + e1[129] * wb + wn, il = 1.f / L;
                om[mp][0] = (e0[2 * lane] * wa + e1[2 * lane] * wb + vn[2 * lane] * wn) * il; om[mp][1] = (e0[2 * lane + 1] * wa + e1[2 * lane + 1] * wb + vn[2 * lane + 1] * wn) * il; }
            const float o0 = om[0][0] - lam * om[1][0], o1 = om[0][1] - lam * om[1][1];
            const float rstd = SUBLN_SCALE / sqrtf(wave_sum(o0 * o0 + o1 * o1) * (1.f / 128.f) + 1e-5f);
            *(unsigned*)(AMIX + (size_t)(MP + b) * DM + 512 + head * 128 + 2 * lane) = pk2(o0 * rstd * INF(I_SUBG)[2 * lane], o1 * rstd * INF(I_SUBG)[2 * lane + 1]); }
        if (BOTH(3)) GRID_BAR();
    }

    if (IN(4)) {
        const int lane = lane_now(), tid = F.wave * 64 + lane; (void)tid;
        { pg8::Gemm g{AMIX, WOUT, MP, DM, DM}; pg8::StaticOrder S; S.init(MP, DM, F.G, (int)blockIdx.x); EpiF32 E{MIX, DM};
          pg8::gemm_phase<EpiF32, pg8::StaticOrder, true, true>(F.lds + RING_OFF, g, S, E); }
        __syncthreads();
        small_gemm<0>(F, AMIX + (size_t)MP * DM, DM, WOUT, DM, DM, MIX + (size_t)MP * DM, DM);
        if (BOTH(4)) GRID_BAR();
    }

    if (IN(5)) {
        const int lane = lane_now(), tid = F.wave * 64 + lane; (void)tid;
        f32x4 g1[4], g2[4]; row_load(INF(I_NPOSTM), lane, g1); row_load(INF(I_NPREF), lane, g2);
        for (int m = gw; m < MTOT; m += NGW) { const float* xr = m < MP ? INF(I_XP) + (size_t)m * DM : INF(I_XS) + (size_t)(m - MP) * DM; f32x4 x[4], v[4]; row_load(xr, lane, x); row_load(MIX + (size_t)m * DM, lane, v);
            const float rstd = 1.f / sqrtf(row_ssq(v) * (1.f / DM) + 1e-6f);
#pragma unroll
            for (int j = 0; j < 4; ++j) x[j] = x[j] + v[j] * rstd * g1[j];
            row_store_f32(X1 + (size_t)m * DM, lane, x);
            const float rstd2 = 1.f / sqrtf(row_ssq(x) * (1.f / DM) + 1e-6f);
#pragma unroll
            for (int j = 0; j < 4; ++j) v[j] = x[j] * rstd2 * g2[j];
            row_store_bf16(XN + (size_t)m * DM, lane, v); }
        if (BOTH(5)) GRID_BAR();
    }

    if (IN(6)) {
        const int lane = lane_now(), tid = F.wave * 64 + lane; (void)tid;
        { pg8::Gemm g{XN, WGU, MP, GU, DM}; pg8::StaticOrder S; S.init(MP, GU, F.G, (int)blockIdx.x); EpiSwiGlu E{HB};
          pg8::gemm_phase<EpiSwiGlu, pg8::StaticOrder, true, true>(F.lds + RING_OFF, g, S, E); }
        __syncthreads();
        small_gemm<0>(F, XN + (size_t)MP * DM, DM, WGU, GU, DM, GUS, GU);
        if (BOTH(6)) GRID_BAR();
    }

    if (IN(7)) {
        const int lane = lane_now(), tid = F.wave * 64 + lane; (void)tid;
        { pg8::Gemm g{HB, WD, MP, DM, FF}; pg8::StaticOrder S; S.init(MP, DM, F.G, (int)blockIdx.x); EpiF32 E{MIX, DM};
          pg8::gemm_phase<EpiF32, pg8::StaticOrder, true, true>(F.lds + RING_OFF, g, S, E); }
        __syncthreads();
        small_gemm<2>(F, GUS, GU, WD, DM, FF, MIX + (size_t)MP * DM, DM);
        if (BOTH(7)) GRID_BAR();
    }

    if (IN(8)) {
        const int lane = lane_now(), tid = F.wave * 64 + lane; (void)tid;
        f32x4 g1[4]; row_load(INF(I_NPOSTF), lane, g1);
        for (int m = gw; m < MTOT; m += NGW) { f32x4 x[4], v[4]; row_load(X1 + (size_t)m * DM, lane, x); row_load(MIX + (size_t)m * DM, lane, v);
            const float rstd = 1.f / sqrtf(row_ssq(v) * (1.f / DM) + 1e-6f);
#pragma unroll
            for (int j = 0; j < 4; ++j) x[j] = x[j] + v[j] * rstd * g1[j];
            row_store_f32(X1 + (size_t)m * DM, lane, x); row_store_bf16(XN + (size_t)m * DM, lane, x); }
        if (BOTH(8)) GRID_BAR();
    }

    if (IN(9)) {
        const int lane = lane_now(), tid = F.wave * 64 + lane; (void)tid;
        { pg8::Gemm g{XN, WPG, MP, DM, DM}; pg8::StaticOrder S; S.init(MP, DM, F.G, (int)blockIdx.x); EpiPle E{PROJ, MIX};
          pg8::gemm_phase<EpiPle, pg8::StaticOrder, true, true>(F.lds + RING_OFF, g, S, E); }
        __syncthreads();
        small_gemm<0>(F, XN + (size_t)MP * DM, DM, WPG, DM, DM, GS, DM);
        if (BOTH(9)) GRID_BAR();
    }

    if (IN(10)) {
        const int lane = lane_now(), tid = F.wave * 64 + lane; (void)tid;
        f32x4 g1[4]; row_load(INF(I_PNORM), lane, g1);
        for (int m = gw; m < MTOT; m += NGW) { f32x4 x[4], v[4]; row_load(X1 + (size_t)m * DM, lane, x);
            if (m < MP) row_load(MIX + (size_t)m * DM, lane, v);
            else { f32x4 a[4], b[4]; row_load(GS + (size_t)(m - MP) * DM, lane, a); row_load(PJS + (size_t)(m - MP) * DM, lane, b);
#pragma unroll
                for (int j = 0; j < 4; ++j) { v[j].x = sigmoidf_(a[j].x) * b[j].x; v[j].y = sigmoidf_(a[j].y) * b[j].y; v[j].z = sigmoidf_(a[j].z) * b[j].z; v[j].w = sigmoidf_(a[j].w) * b[j].w; } }
            const float rstd = 1.f / sqrtf(row_ssq(v) * (1.f / DM) + 1e-6f);
#pragma unroll
            for (int j = 0; j < 4; ++j) x[j] = x[j] + v[j] * rstd * g1[j];
            row_store_f32(m < MP ? args.out + OY_P + (size_t)m * DM : args.out + OY_S + (size_t)(m - MP) * DM, lane, x); }
    }
#undef IN
#undef BOTH
#undef INF
}

extern "C" void kernel_launch(void* const* d_in, const int* in_sizes, int n_in, void* d_out, int out_size, void* d_ws, size_t ws_size, hipStream_t stream) {
    static int grid = 0;
    if (grid == 0) {
        if (n_in != 33 || (size_t)out_size != OUT_TOTAL || ws_size < WS_END) { fprintf(stderr, "kernel_launch: unexpected sizes (n_in %d, out %d, ws %zu, need %zu)\n", n_in, out_size, ws_size, (size_t)WS_END); grid = -1; return; }
        int dev = 0, cus = 0, per_cu = 0;
        if (hipGetDevice(&dev) != hipSuccess || hipDeviceGetAttribute(&cus, hipDeviceAttributeMultiprocessorCount, dev) != hipSuccess) { grid = -1; return; }
        if (hipFuncSetAttribute((const void*)hymba_fwd, hipFuncAttributeMaxDynamicSharedMemorySize, LDS_BYTES) != hipSuccess) { fprintf(stderr, "kernel_launch: hipFuncSetAttribute failed\n"); grid = -1; return; }
        if (hipOccupancyMaxActiveBlocksPerMultiprocessor(&per_cu, (const void*)hymba_fwd, NWAVES * 64, LDS_BYTES) != hipSuccess || per_cu < 1) { fprintf(stderr, "kernel_launch: occupancy query says %d\n", per_cu); }
        (void)hipGetLastError();
        grid = cus;
    }
    if (grid < 0) return;
    (void)hipMemsetAsync((char*)d_ws + WS_CTL, 0, CTL_ZERO_BYTES, stream);
    Args a{};
    for (int i = 0; i < 33; ++i) a.in[i] = d_in[i];
    a.out = (float*)d_out; a.ws = (unsigned char*)d_ws;
    for (int i = 0; i < 8; ++i) a.inv_freq[i] = (float)pow(500000.0, -(double)i / 8.0);
    constexpr int NL = MK_N_LAUNCHES;
    for (int li = 0; li < NL; ++li) {
        a.ph_lo = (NL == 1) ? 0 : li; a.ph_hi = (NL == 1) ? N_PHASES : li + 1; a.li = (NL == 1) ? 0 : 0; a.pad = 0;
        hipLaunchKernelGGL(hymba_fwd, dim3(grid), dim3(NWAVES * 64), LDS_BYTES, stream, a);
    }
}
```

```cpp
#include <hip/hip_runtime.h>
__device__ __forceinline__ int lane_now() { int l; asm volatile("v_mbcnt_lo_u32_b32 %0, -1, 0\n\tv_mbcnt_hi_u32_b32 %0, -1, %0" : "=v"(l)); return l; }
#include <hip/hip_runtime.h>
#include <cstdio>
#include <cstdint>
namespace pg8 {
#define PG8_LAS __attribute__((address_space(3)))
typedef unsigned short bf16_t;
typedef short bf16x8 __attribute__((ext_vector_type(8)));
typedef float f32x4 __attribute__((ext_vector_type(4)));
typedef unsigned u32x4 __attribute__((ext_vector_type(4)));
constexpr int BM = 256, BK = 64, HALF = 128, HTB = HALF * BK * 2  , STAGE_BYTES = 8 * HTB, NXCD = 8, WGM = 8;

__host__ __device__ __forceinline__ int lds_byte(int r, int c) { const int st = (r >> 4) * 2 + (c >> 5), rr = r & 15, cc = c & 31, ob = rr * 64 + cc * 2; return st * 1024 + (ob ^ (((ob >> 9) & 1) << 5)); }
__host__ __device__ __forceinline__ void stage_rc(int b, int& R, int& C) { const int st = b / 1024, sb = b % 1024, swz = sb ^ (((sb >> 9) & 1) << 5); R = (st >> 1) * 16 + swz / 64; C = (st & 1) * 32 + (swz % 64) / 2; }
__host__ __device__ __forceinline__ int perm32(int rho) { const int n = rho >> 4, i = rho & 15; return 8 * (i >> 2) + 4 * n + (i & 3); }

struct Unit { int pm, pn; };
struct Gemm { const bf16_t* A; const bf16_t* Bt; int M, N, K; };

struct StaticOrder {
    int nM, nN, nwg, G, c;
    __host__ __device__ void init(int M, int N, int G_, int c_) { nM = M / BM; nN = N / BM; nwg = nM * nN; G = G_; c = c_; }
    __host__ __device__ bool next(int i, Unit& u) const {
        const long L = (long)i * G + c; if (L >= nwg) return false;
        int wgid = (int)L; { const int q = nwg / NXCD, r = nwg % NXCD, xcd = wgid % NXCD, off = wgid / NXCD; wgid = (xcd < r ? xcd * (q + 1) : r * (q + 1) + (xcd - r) * q) + off; }
        const int nig = WGM * nN, gid = wgid / nig, fm = gid * WGM, gsz = (nM - fm) < WGM ? (nM - fm) : WGM;
        u.pm = fm + ((wgid % nig) % gsz); u.pn = (wgid % nig) / gsz; return true;
    }
    __device__ __forceinline__ void a_ready(const Unit&) const {}
    __device__ __forceinline__ void done(const Unit&) const {}
};

typedef float f32x2 __attribute__((ext_vector_type(2)));
template <class Epi, class Sched, bool ALIGN_EPI = false, bool SP2 = false>
__device__ __forceinline__ void gemm_phase(PG8_LAS unsigned char* lds, const Gemm g, const Sched& S, const Epi& E) {
    const int tid = threadIdx.x, wid = __builtin_amdgcn_readfirstlane(tid >> 6), lane = tid & 63, wr = wid >> 2, wc = wid & 3, fr = lane & 15, fq = lane >> 4;
    const int K = g.K, nt = K / BK;
    unsigned voffA[2], voffB[2];
#pragma unroll
    for (int i = 0; i < 2; ++i) { int R, C; stage_rc(tid * 16 + i * 8192, R, C); const int Rb = Epi::PERM ? ((R & ~31) + perm32(R & 31)) : R;
        voffA[i] = (unsigned)(R * K + C) * 2u; voffB[i] = (unsigned)(Rb * K + C) * 2u; }
    const size_t kstep = (size_t)(BK * 2);
    const size_t hstep = (size_t)HALF * K * 2;
    const size_t tstep = 2 * hstep;
    const unsigned ldsw = (unsigned)wid * 1024u;
    const int aoff = lds_byte(wr * 64 + fr, fq * 8), boff = lds_byte(wc * 32 + fr, fq * 8);
#define PG8_SA(b, h) (((b) * 2 + (h)) * HTB)
#define PG8_SB(b, h) ((4 + (b) * 2 + (h)) * HTB)
#define PG8_STAGE(bufoff, gbase, voff) do { _Pragma("unroll") for (int _i = 0; _i < 2; ++_i) \
        __builtin_amdgcn_global_load_lds((const unsigned*)((const char*)(gbase) + (voff)[_i]), (PG8_LAS unsigned*)(lds + (bufoff) + ldsw + _i * 8192), 16, 0, 0); } while (0)
#define PG8_LDA(dst, b, h) do { _Pragma("unroll") for (int m = 0; m < 4; ++m) _Pragma("unroll") for (int k = 0; k < 2; ++k) dst[m][k] = *(const PG8_LAS bf16x8*)(lds + PG8_SA(b, h) + aoff + m * 2048 + k * 1024); } while (0)
#define PG8_LDB(dst, b, h) do { _Pragma("unroll") for (int n = 0; n < 2; ++n) _Pragma("unroll") for (int k = 0; k < 2; ++k) dst[n][k] = *(const PG8_LAS bf16x8*)(lds + PG8_SB(b, h) + boff + n * 2048 + k * 1024); } while (0)
#define PG8_MMA(ai, bj, At, Bt) do { __builtin_amdgcn_s_setprio(1); _Pragma("unroll") for (int m = 0; m < 4; ++m) _Pragma("unroll") for (int n = 0; n < 2; ++n) _Pragma("unroll") for (int k = 0; k < 2; ++k) \
        acc[ai][bj][m][n] = __builtin_amdgcn_mfma_f32_16x16x32_bf16(Bt[n][k], At[m][k], acc[ai][bj][m][n], 0, 0, 0); __builtin_amdgcn_s_setprio(0); } while (0)
#define PG8_WAIT_V(n) asm volatile("s_waitcnt vmcnt(" #n ")" ::: "memory")
#define PG8_WAIT_L(n) asm volatile("s_waitcnt lgkmcnt(" #n ")" ::: "memory")
#define PG8_BAR __builtin_amdgcn_s_barrier()
#define PG8_SCHED __builtin_amdgcn_sched_barrier(0)
    Unit cur, nxt; int ui = 0;
    if (!S.next(0, cur)) return;
    f32x4 acc[2][2][4][2];
#pragma unroll
    for (int a = 0; a < 2; ++a)
#pragma unroll
        for (int b = 0; b < 2; ++b)
#pragma unroll
            for (int m = 0; m < 4; ++m)
#pragma unroll
                for (int n = 0; n < 2; ++n) acc[a][b][m][n] = (f32x4){0.f, 0.f, 0.f, 0.f};
    bf16x8 At[4][2], B0[2][2], B1[2][2];
    const char* cA = (const char*)g.A + (size_t)cur.pm * tstep; const char* cB = (const char*)g.Bt + (size_t)cur.pn * tstep;
    S.a_ready(cur);
    if constexpr (SP2) {
        PG8_STAGE(PG8_SB(0, 0), cB, voffB); PG8_STAGE(PG8_SB(0, 1), cB + hstep, voffB); PG8_STAGE(PG8_SA(0, 0), cA, voffA); PG8_STAGE(PG8_SA(0, 1), cA + hstep, voffA);
        if (wr == 1) PG8_BAR;
        PG8_WAIT_V(2); PG8_BAR;
        PG8_STAGE(PG8_SB(1, 0), cB + kstep, voffB); PG8_STAGE(PG8_SA(1, 0), cA + kstep, voffA); PG8_STAGE(PG8_SB(1, 1), cB + hstep + kstep, voffB);
        PG8_WAIT_V(6); PG8_BAR;
    } else {
        PG8_STAGE(PG8_SB(0, 0), cB, voffB); PG8_STAGE(PG8_SA(0, 0), cA, voffA); PG8_STAGE(PG8_SB(0, 1), cB + hstep, voffB); PG8_STAGE(PG8_SA(0, 1), cA + hstep, voffA);
        if (wr == 1) PG8_BAR;
        PG8_WAIT_V(4); PG8_BAR;
        PG8_STAGE(PG8_SB(1, 0), cB + kstep, voffB); PG8_STAGE(PG8_SA(1, 0), cA + kstep, voffA); PG8_STAGE(PG8_SB(1, 1), cB + hstep + kstep, voffB);
        PG8_WAIT_V(6); PG8_BAR;
    }
    for (;;) {
        const bool has_next = S.next(ui + 1, nxt);
        const char* nA = has_next ? (const char*)g.A + (size_t)nxt.pm * tstep : cA; const char* nB = has_next ? (const char*)g.Bt + (size_t)nxt.pn * tstep : cB;
        for (int t = 0; t < nt; t += 2) {
            const bool last = (t == nt - 2);
            const char* a1 = cA + (size_t)(t + 1) * kstep;
            const char* a2 = last ? nA : cA + (size_t)(t + 2) * kstep; const char* b2 = last ? nB : cB + (size_t)(t + 2) * kstep;
            const char* a3 = a2 + kstep; const char* b3 = b2 + kstep;
            if (last && has_next) S.a_ready(nxt);
            if constexpr (SP2) {
            PG8_LDB(B0, 0, 0); PG8_LDB(B1, 0, 1); PG8_SCHED; PG8_LDA(At, 0, 0); PG8_STAGE(PG8_SA(1, 1), a1 + hstep, voffA);
            PG8_WAIT_V(8); PG8_WAIT_L(0); PG8_BAR; PG8_MMA(0, 0, At, B0); PG8_MMA(0, 1, At, B1); PG8_BAR; PG8_SCHED;
            PG8_LDA(At, 0, 1); PG8_STAGE(PG8_SB(0, 0), b2, voffB); PG8_STAGE(PG8_SB(0, 1), b2 + hstep, voffB); PG8_STAGE(PG8_SA(0, 0), a2, voffA);
            PG8_WAIT_V(8); PG8_WAIT_L(0); PG8_BAR; PG8_MMA(1, 0, At, B0); PG8_MMA(1, 1, At, B1); PG8_BAR; PG8_SCHED;
            PG8_LDB(B0, 1, 0); PG8_LDB(B1, 1, 1); PG8_SCHED; PG8_LDA(At, 1, 0); PG8_STAGE(PG8_SA(0, 1), a2 + hstep, voffA);
            PG8_WAIT_V(8); PG8_WAIT_L(0); PG8_BAR; PG8_MMA(0, 0, At, B0); PG8_MMA(0, 1, At, B1); PG8_BAR; PG8_SCHED;
            PG8_LDA(At, 1, 1); PG8_STAGE(PG8_SB(1, 0), b3, voffB); PG8_STAGE(PG8_SB(1, 1), b3 + hstep, voffB); PG8_STAGE(PG8_SA(1, 0), a3, voffA);
            PG8_WAIT_V(8); PG8_WAIT_L(0); PG8_BAR; PG8_MMA(1, 0, At, B0); PG8_MMA(1, 1, At, B1); PG8_BAR; PG8_SCHED;
            } else {
            PG8_LDB(B0, 0, 0); PG8_SCHED; PG8_LDA(At, 0, 0); PG8_STAGE(PG8_SA(1, 1), a1 + hstep, voffA);
            PG8_WAIT_L(8); PG8_BAR; PG8_WAIT_L(0); PG8_MMA(0, 0, At, B0); PG8_BAR; PG8_SCHED;
            PG8_LDB(B1, 0, 1); PG8_STAGE(PG8_SB(0, 0), b2, voffB);
            PG8_BAR; PG8_WAIT_L(0); PG8_MMA(0, 1, At, B1); PG8_BAR;
            PG8_LDA(At, 0, 1); PG8_STAGE(PG8_SA(0, 0), a2, voffA);
            PG8_BAR; PG8_WAIT_L(0); PG8_MMA(1, 0, At, B0); PG8_BAR; PG8_SCHED;
            PG8_STAGE(PG8_SB(0, 1), b2 + hstep, voffB);
            PG8_WAIT_V(6); PG8_BAR; PG8_MMA(1, 1, At, B1); PG8_BAR;
            PG8_LDB(B0, 1, 0); PG8_SCHED; PG8_LDA(At, 1, 0); PG8_STAGE(PG8_SA(0, 1), a2 + hstep, voffA);
            PG8_WAIT_L(8); PG8_BAR; PG8_WAIT_L(0); PG8_MMA(0, 0, At, B0); PG8_BAR; PG8_SCHED;
            PG8_LDB(B1, 1, 1); PG8_STAGE(PG8_SB(1, 0), b3, voffB);
            PG8_BAR; PG8_WAIT_L(0); PG8_MMA(0, 1, At, B1); PG8_BAR;
            PG8_LDA(At, 1, 1); PG8_STAGE(PG8_SA(1, 0), a3, voffA);
            PG8_BAR; PG8_WAIT_L(0); PG8_MMA(1, 0, At, B0); PG8_BAR; PG8_SCHED;
            PG8_STAGE(PG8_SB(1, 1), b3 + hstep, voffB);
            PG8_WAIT_V(6); PG8_BAR; PG8_MMA(1, 1, At, B1); PG8_BAR;
            }
        }
        if constexpr (ALIGN_EPI) { if (wr == 0) PG8_BAR; }
        if constexpr (!Epi::AFTER_DRAIN) { E(acc, cur, wr, wc, fr, fq); S.done(cur); }
        if (!has_next) break;
#pragma unroll
        for (int a = 0; a < 2; ++a)
#pragma unroll
            for (int b = 0; b < 2; ++b)
#pragma unroll
                for (int m = 0; m < 4; ++m)
#pragma unroll
                    for (int n = 0; n < 2; ++n) acc[a][b][m][n] = (f32x4){0.f, 0.f, 0.f, 0.f};
        cur = nxt; cA = nA; cB = nB; ++ui;
        if constexpr (ALIGN_EPI) { if (wr == 1) PG8_BAR; }
    }
    PG8_WAIT_V(0);
    if constexpr (!ALIGN_EPI) { if (wr == 0) PG8_BAR; }
    PG8_BAR;
    if constexpr (Epi::AFTER_DRAIN) { E.fused(acc, cur, wr, wc, fr, fq, lds, wid, lane); S.done(cur); }
#undef PG8_SA
#undef PG8_SB
#undef PG8_STAGE
#undef PG8_LDA
#undef PG8_LDB
#undef PG8_MMA
#undef PG8_WAIT_V
#undef PG8_WAIT_L
#undef PG8_BAR
#undef PG8_SCHED
}
}

#include <hip/hip_bf16.h>
#include <cmath>
namespace attn_body {
using bf16=__hip_bfloat16;
using bf16x8=__attribute__((ext_vector_type(8)))short;
using s16x4=__attribute__((ext_vector_type(4)))short;
using f32x16=__attribute__((ext_vector_type(16)))float;
using u32x4=__attribute__((ext_vector_type(4)))unsigned;
constexpr int BATCH=2,NHEAD=16,SEQ=8192,D=64,PQ=512,PO=1024;
constexpr int NW=8,QBLK=32,QB=QBLK*NW,KVBLK=64,NQB=SEQ/QB;
constexpr int ATTN_UNIT_ROWS=QB;
__device__ __forceinline__ int crow(int r,int hi){return (r&3)+8*(r>>2)+4*hi;}
#define SBAR() __builtin_amdgcn_sched_barrier(0)
__device__ __forceinline__ void cmask(f32x16&p0,f32x16&p1,int jb,int qrel,int hi){
  const float NEG=-INFINITY; int kb=64*jb+4*hi;
  #pragma unroll
  for(int r=0;r<16;++r){int kv=kb+(r&3)+8*(r>>2); if(kv>qrel)p0[r]=NEG; if(kv+32>qrel)p1[r]=NEG;}
}

constexpr int NSLOT=3, SLOTB=8192;
constexpr int LDS_K=0, LDS_V=NSLOT*SLOTB, LDS_WS=2*NSLOT*SLOTB, LDS_OST=LDS_WS+NW*64*4, LDS_BYTES=LDS_OST+NW*4096;
constexpr float C2=0.125f*1.4426950408889634f;
__device__ __forceinline__ void glds16(const void*gsrc,unsigned lds_dst){unsigned keep;
  asm volatile("s_mov_b32 %0, m0\n\ts_mov_b32 m0, %2\n\ts_nop 0\n\tglobal_load_lds_dwordx4 %1, off\n\ts_mov_b32 m0, %0":"=&s"(keep):"v"(gsrc),"s"(lds_dst):"memory");}
__device__ __forceinline__ float max3f(float a,float b,float c){float r;asm("v_max3_f32 %0, %1, %2, %3":"=v"(r):"v"(a),"v"(b),"v"(c));return r;}
__device__ __forceinline__ float max2f(float a,float b){float r;asm("v_max_f32_e32 %0, %1, %2":"=v"(r):"v"(a),"v"(b));return r;}
__device__ __forceinline__ float fadd_s(float a,float b){float r;asm("v_add_f32_e32 %0, %1, %2":"=v"(r):"v"(a),"v"(b));return r;}
__device__ __forceinline__ float fsub_s(float a,float b){float r;asm("v_sub_f32_e32 %0, %1, %2":"=v"(r):"v"(a),"v"(b));return r;}
typedef float f32x2_t __attribute__((ext_vector_type(2))); typedef __bf16 bf16x2_t __attribute__((ext_vector_type(2)));
__device__ __forceinline__ unsigned cvtpk_s(float lo,float hi){f32x2_t v={lo,hi};bf16x2_t b=__builtin_convertvector(v,bf16x2_t);return __builtin_bit_cast(unsigned,b);}
#define WAIT_BAR(N) asm volatile("s_waitcnt vmcnt(" #N ") lgkmcnt(0)\n\ts_barrier":::"memory")

__device__ __forceinline__ void qkt(f32x16&p0,f32x16&p1,const char*Kslot,const bf16x8*qr,const f32x16&negm,int r32,int hi){
  const char*kb=Kslot+hi*1024+r32*16;
  #pragma unroll
  for(int d0=0;d0<4;++d0){
    const bf16x8 b0=*reinterpret_cast<const bf16x8*>(kb+d0*2048);
    const bf16x8 b1=*reinterpret_cast<const bf16x8*>(kb+d0*2048+512);
    if(d0==0){p0=__builtin_amdgcn_mfma_f32_32x32x16_bf16(b0,qr[0],negm,0,0,0);p1=__builtin_amdgcn_mfma_f32_32x32x16_bf16(b1,qr[0],negm,0,0,0);}
    else{p0=__builtin_amdgcn_mfma_f32_32x32x16_bf16(b0,qr[d0],p0,0,0,0);p1=__builtin_amdgcn_mfma_f32_32x32x16_bf16(b1,qr[d0],p1,0,0,0);}}
}
typedef __attribute__((address_space(3))) const char* lds_cptr;
typedef short v4i16_t __attribute__((ext_vector_type(4)));
__device__ __forceinline__ void kload8(bf16x8*kf,lds_cptr kp){
  kf[0]=*(const __attribute__((address_space(3))) bf16x8*)(kp);      kf[1]=*(const __attribute__((address_space(3))) bf16x8*)(kp+512);
  kf[2]=*(const __attribute__((address_space(3))) bf16x8*)(kp+2048); kf[3]=*(const __attribute__((address_space(3))) bf16x8*)(kp+2560);
  kf[4]=*(const __attribute__((address_space(3))) bf16x8*)(kp+4096); kf[5]=*(const __attribute__((address_space(3))) bf16x8*)(kp+4608);
  kf[6]=*(const __attribute__((address_space(3))) bf16x8*)(kp+6144); kf[7]=*(const __attribute__((address_space(3))) bf16x8*)(kp+6656);
}
__device__ __forceinline__ void kload2(bf16x8*kf,lds_cptr kp,int j){ kf[2*j]=*(const __attribute__((address_space(3))) bf16x8*)(kp+j*2048); kf[2*j+1]=*(const __attribute__((address_space(3))) bf16x8*)(kp+j*2048+512); }
__device__ __forceinline__ s16x4 vtr(lds_cptr p){ return __builtin_bit_cast(s16x4,__builtin_amdgcn_ds_read_tr16_b64_v4i16((__attribute__((address_space(3))) v4i16_t*)p)); }
__device__ __forceinline__ float rowmax(const f32x16&p0,const f32x16&p1){
  float a=max3f(p0[0],p0[1],p1[0]),b=max3f(p0[2],p0[3],p1[1]);a=max3f(a,p1[2],p1[3]);
  #pragma unroll
  for(int r=4;r<16;r+=4){a=max3f(a,p0[r],p0[r+1]);b=max3f(b,p0[r+2],p0[r+3]);a=max3f(a,p1[r],p1[r+1]);b=max3f(b,p1[r+2],p1[r+3]);}
  const float m=max2f(a,b);
  auto rr=__builtin_amdgcn_permlane32_swap(__float_as_uint(m),__float_as_uint(m),false,false);
  return max2f(__uint_as_float(rr[0]),__uint_as_float(rr[1]));
}
__device__ __forceinline__ void pv(f32x16*o,int vb,bf16x8 pa0,bf16x8 pa1,bf16x8 pa2,bf16x8 pa3){
  #pragma unroll
  for(int d0=0;d0<2;++d0){s16x4 lo[4],hi[4];
    #pragma unroll
    for(int ks=0;ks<4;++ks){
      asm volatile("ds_read_b64_tr_b16 %0,%1 offset:%c2":"=&v"(lo[ks]):"v"(vb),"i"(d0*4096+ks*1024):"memory");
      asm volatile("ds_read_b64_tr_b16 %0,%1 offset:%c2":"=&v"(hi[ks]):"v"(vb),"i"(d0*4096+ks*1024+512):"memory");}
    asm volatile("s_waitcnt lgkmcnt(0)":::"memory");SBAR();
    #define PK(k) (bf16x8){lo[k][0],lo[k][1],lo[k][2],lo[k][3],hi[k][0],hi[k][1],hi[k][2],hi[k][3]}
    o[d0]=__builtin_amdgcn_mfma_f32_32x32x16_bf16(pa0,PK(0),o[d0],0,0,0);
    o[d0]=__builtin_amdgcn_mfma_f32_32x32x16_bf16(pa1,PK(1),o[d0],0,0,0);
    o[d0]=__builtin_amdgcn_mfma_f32_32x32x16_bf16(pa2,PK(2),o[d0],0,0,0);
    o[d0]=__builtin_amdgcn_mfma_f32_32x32x16_bf16(pa3,PK(3),o[d0],0,0,0);
    #undef PK
  }
}

#ifndef ATTN_STORE16
#define ATTN_STORE16(p,v) (*(u32x4*)(p)=(v))
#endif
template<int THRL> __device__ __forceinline__ void attn_unit(int b,int qoff,int koff,int voff,int ooff,int qb,const bf16*Q,const bf16*__restrict__ K,const bf16*__restrict__ V,bf16*O,char*shm){
  const int tid=threadIdx.x,lane=tid&63,r32=lane&31,hi=lane>>5; const int wid=__builtin_amdgcn_readfirstlane(tid>>6);
  const long rowbase=(long)b*SEQ; const int q0=qb*QB;
  const bf16*Qw=Q+(rowbase+q0+wid*QBLK)*PQ+qoff;
  const bf16*Kh=K+rowbase*PQ+koff,*Vh=V+rowbase*PQ+voff;
  const unsigned lds0=(unsigned)(uintptr_t)shm;
  float*wsf=(float*)(shm+LDS_WS)+wid*64;
  const bf16*ksrc=Kh+(long)lane*PQ+wid*8;
  const bf16*vsrc=Vh+(long)(16*(wid&3)+(lane>>2))*PQ+(wid>>2)*32+(lane&3)*8;
  const unsigned kdst=lds0+LDS_K+wid*1024, vdst=lds0+LDS_V+wid*1024;
  #define DMA_K(t,slot) glds16(ksrc+(long)(t)*KVBLK*PQ,(unsigned)__builtin_amdgcn_readfirstlane(kdst+(slot)))
  #define DMA_V(t,slot) glds16(vsrc+(long)(t)*KVBLK*PQ,(unsigned)__builtin_amdgcn_readfirstlane(vdst+(slot)))
  const int vb0=(int)(lds0+LDS_V)+((lane>>4)&1)*32+(lane&3)*8+(4*hi+((lane&15)>>2))*64;
  const char*Kbase=shm+LDS_K; bf16x8 kf[8];
  const lds_cptr shm3=(lds_cptr)shm; const lds_cptr kp0=shm3+LDS_K+hi*1024+r32*16; const lds_cptr vp0=shm3+LDS_V+((lane>>4)&1)*32+(lane&3)*8+(4*hi+((lane&15)>>2))*64;
  const int NT=(q0+QB)/KVBLK;
  DMA_K(0,0);DMA_V(0,0);DMA_K(1,SLOTB);
  bf16x8 qr[4];
  #pragma unroll
  for(int d0=0;d0<4;++d0)qr[d0]=*reinterpret_cast<const bf16x8*>(&Qw[(long)r32*PQ+d0*16+hi*8]);
  float mhat=0.f,l_reg=0.f;f32x16 o[2];o[0]=f32x16{};o[1]=f32x16{};f32x16 negm=f32x16{};asm volatile("":"+v"(negm));
  const int qrel=wid*QBLK+r32;
  #define CMASK(P0,P1,t) do{int jb_=(t)-(NT-4); if(jb_>=0)cmask(P0,P1,jb_,qrel,hi);}while(0)
  bool resc=false;
  #define START(P0,P1) do{ const float rm=rowmax(P0,P1); resc=false; \
    { const float dl=rm; mhat=fadd_s(mhat,dl); \
      _Pragma("unroll") for(int r=0;r<16;++r){P0[r]=fsub_s(P0[r],dl);P1[r]=fsub_s(P1[r],dl);} \
      _Pragma("unroll") for(int r=0;r<16;++r)negm[r]=-mhat; asm volatile("":"+v"(negm)); } \
    _Pragma("unroll") for(int r=0;r<16;++r)P0[r]=__builtin_amdgcn_exp2f(P0[r]); }while(0)
  #define RESC() do{ if(resc){ asm volatile("s_waitcnt lgkmcnt(0)":::"memory"); \
      _Pragma("unroll") for(int d_=0;d_<2;++d_) _Pragma("unroll") for(int r=0;r<16;++r)o[d_][r]*=wsf[crow(r,hi)]; } }while(0)
  f32x16 pA0,pA1,pB0,pB1;
  int sl_prev=0,sl_cur=0,sl_next=SLOTB;
  #define ROT() do{sl_prev=sl_cur;sl_cur=sl_next;sl_next=(sl_next==(NSLOT-1)*SLOTB)?0:sl_next+SLOTB;}while(0)
  DMA_K(2,2*SLOTB);
  WAIT_BAR(3);
  qkt(pA0,pA1,Kbase,qr,negm,r32,hi);asm volatile("s_nop 15\n\ts_nop 7":"+v"(pA0),"+v"(pA1));CMASK(pA0,pA1,0);
  START(pA0,pA1);
  _Pragma("unroll") for(int r=0;r<16;++r)pA1[r]=__builtin_amdgcn_exp2f(pA1[r]);
  WAIT_BAR(0);
  DMA_K(3,0);DMA_V(1,SLOTB);
  ROT();
  kload8(kf,kp0+sl_cur);
  WAIT_BAR(2);
  s16x4 vlo[8],vhi[8]; u32x4 pw0,pw1,pw2,pw3;
  #define PKW(P,B) cvtpk_s(P[B],P[B+1])
  #define PAF(k) __builtin_bit_cast(bf16x8,pw##k)
  #define VFR(i) (bf16x8){vlo[i][0],vlo[i][1],vlo[i][2],vlo[i][3],vhi[i][0],vhi[i][1],vhi[i][2],vhi[i][3]}
  #define PIN(x) asm volatile("":"+v"(x))
  #define MX3(a,b,c) __builtin_fmaxf(__builtin_fmaxf((a),(b)),(c))
  #define GAPA(MF,A0,A1,A2,A3,W0,W1,PW) do{ MF; sacc+=A0; sacc+=A1; sacc+=A2; sacc+=A3; PIN(sacc); W0; W1; PIN(PW); SBAR(); }while(0)
  #define EX(v) __builtin_amdgcn_exp2f(v)
  #define GAPB(MF,X,B) do{ MF; X[B]=EX(X[B]); X[B+1]=EX(X[B+1]); X[B+2]=EX(X[B+2]); X[B+3]=EX(X[B+3]); PIN(X); SBAR(); }while(0)
  #define VRD(i) do{ vlo[i]=vtr(vp_+(((i)>>2)*4096+((i)&3)*1024)); vhi[i]=vtr(vp_+(((i)>>2)*4096+((i)&3)*1024+512)); }while(0)
  #define KRD(G,j) do{ if(G){ kload2(kf,kp0+sl_next,j); SBAR(); } }while(0)
  #define STEP(C0,C1,P0,P1,t,GK,GV,GL) do{ SBAR(); \
    const lds_cptr vp_=vp0+sl_prev; \
    VRD(0); SBAR(); float sacc=(P0[0]+P0[1]); \
    GAPA(C0=__builtin_amdgcn_mfma_f32_32x32x16_bf16(kf[0],qr[0],negm,0,0,0), P0[2],P0[3],P0[4],P0[5],     pw0[0]=PKW(P0,0), pw0[1]=PKW(P0,2), pw0); \
    VRD(4); SBAR(); GAPA(C1=__builtin_amdgcn_mfma_f32_32x32x16_bf16(kf[1],qr[0],negm,0,0,0), P0[6],P0[7],P0[8],P0[9],     pw0[2]=PKW(P0,4), pw0[3]=PKW(P0,6), pw0); \
    VRD(1); SBAR(); GAPA(C0=__builtin_amdgcn_mfma_f32_32x32x16_bf16(kf[2],qr[1],C0,0,0,0),   P0[10],P0[11],P0[12],P0[13], pw1[0]=PKW(P0,8), pw1[1]=PKW(P0,10), pw1); \
    VRD(5); SBAR(); GAPA(C1=__builtin_amdgcn_mfma_f32_32x32x16_bf16(kf[3],qr[1],C1,0,0,0),   P0[14],P0[15],P1[0],P1[1],   pw1[2]=PKW(P0,12),pw1[3]=PKW(P0,14), pw1); \
    VRD(2); SBAR(); GAPA(C0=__builtin_amdgcn_mfma_f32_32x32x16_bf16(kf[4],qr[2],C0,0,0,0),   P1[2],P1[3],P1[4],P1[5],     pw2[0]=PKW(P1,0), pw2[1]=PKW(P1,2), pw2); \
    VRD(6); SBAR(); GAPA(C1=__builtin_amdgcn_mfma_f32_32x32x16_bf16(kf[5],qr[2],C1,0,0,0),   P1[6],P1[7],P1[8],P1[9],     pw2[2]=PKW(P1,4), pw2[3]=PKW(P1,6), pw2); \
    VRD(3); SBAR(); GAPA(C0=__builtin_amdgcn_mfma_f32_32x32x16_bf16(kf[6],qr[3],C0,0,0,0),   P1[10],P1[11],P1[12],P1[13], pw3[0]=PKW(P1,8), pw3[1]=PKW(P1,10), pw3); \
    VRD(7); SBAR(); GAPA(C1=__builtin_amdgcn_mfma_f32_32x32x16_bf16(kf[7],qr[3],C1,0,0,0),   P1[14],P1[15],0.f,0.f,       pw3[2]=PKW(P1,12),pw3[3]=PKW(P1,14), pw3); \
    l_reg+=sacc; \
    if(GK){DMA_K((t)+3,sl_cur);} if(GV){DMA_V((t)+1,sl_next);} \
    CMASK(C0,C1,t); \
    { float a=MX3(C0[0],C0[1],C1[0]),b=MX3(C0[2],C0[3],C1[1]); a=MX3(a,C1[2],C1[3]); \
      _Pragma("unroll") for(int r=4;r<16;r+=4){a=MX3(a,C0[r],C0[r+1]);b=MX3(b,C0[r+2],C0[r+3]);a=MX3(a,C1[r],C1[r+1]);b=MX3(b,C1[r+2],C1[r+3]);} \
      float rm=__builtin_fmaxf(a,b); { auto rr=__builtin_amdgcn_permlane32_swap(__float_as_uint(rm),__float_as_uint(rm),false,false); rm=__builtin_fmaxf(__uint_as_float(rr[0]),__uint_as_float(rr[1])); } \
      resc=false; \
      if(__builtin_expect(__any(rm>(float)THRL),0)){ const float dl=__builtin_fmaxf(rm,0.f); mhat+=dl; \
        _Pragma("unroll") for(int r=0;r<16;++r){C0[r]-=dl;C1[r]-=dl;} \
        _Pragma("unroll") for(int r=0;r<16;++r)negm[r]=-mhat; asm volatile("":"+v"(negm)); \
        const float f=__builtin_amdgcn_exp2f(-dl); l_reg*=f; if(hi==0)wsf[r32]=f; resc=true; } } \
    SBAR(); \
    GAPB(o[0]=__builtin_amdgcn_mfma_f32_32x32x16_bf16(PAF(0),VFR(0),o[0],0,0,0), C0,0); \
    GAPB(o[1]=__builtin_amdgcn_mfma_f32_32x32x16_bf16(PAF(0),VFR(4),o[1],0,0,0), C0,4); \
    KRD(GL,0); GAPB(o[0]=__builtin_amdgcn_mfma_f32_32x32x16_bf16(PAF(1),VFR(1),o[0],0,0,0), C0,8); \
    KRD(GL,1); GAPB(o[1]=__builtin_amdgcn_mfma_f32_32x32x16_bf16(PAF(1),VFR(5),o[1],0,0,0), C0,12); \
    KRD(GL,2); GAPB(o[0]=__builtin_amdgcn_mfma_f32_32x32x16_bf16(PAF(2),VFR(2),o[0],0,0,0), C1,0); \
    KRD(GL,3); GAPB(o[1]=__builtin_amdgcn_mfma_f32_32x32x16_bf16(PAF(2),VFR(6),o[1],0,0,0), C1,4); \
    GAPB(o[0]=__builtin_amdgcn_mfma_f32_32x32x16_bf16(PAF(3),VFR(3),o[0],0,0,0), C1,8); \
    GAPB(o[1]=__builtin_amdgcn_mfma_f32_32x32x16_bf16(PAF(3),VFR(7),o[1],0,0,0), C1,12); \
    }while(0)
  int t=1;
  #undef CMASK
  #define CMASK(P0,P1,t) do{}while(0)
  for(;t+5<NT;t+=2){
    STEP(pB0,pB1,pA0,pA1,t,true,true,true);     WAIT_BAR(2); RESC(); ROT();
    STEP(pA0,pA1,pB0,pB1,t+1,true,true,true);   WAIT_BAR(2); RESC(); ROT();
  }
  #undef CMASK
  #define CMASK(P0,P1,t) do{int jb_=(t)-(NT-4); if(jb_>=0)cmask(P0,P1,jb_,qrel,hi);}while(0)
  #define ENDW(tt) do{ if((tt)+3<NT){WAIT_BAR(2);} else if((tt)+2<NT){WAIT_BAR(1);} else {WAIT_BAR(0);} }while(0)
  for(;t+1<NT;t+=2){
    STEP(pB0,pB1,pA0,pA1,t,(t+3<NT),(t+1<NT),(t+1<NT));       ENDW(t);   RESC(); ROT();
    STEP(pA0,pA1,pB0,pB1,t+1,(t+4<NT),(t+2<NT),(t+2<NT));     ENDW(t+1); RESC(); ROT();
  }
  STEP(pB0,pB1,pA0,pA1,NT-1,false,false,false); RESC();
  { float sacc=pB0[0]+pB0[1]; _Pragma("unroll") for(int r=2;r<16;++r)sacc+=pB0[r]; _Pragma("unroll") for(int r=0;r<16;++r)sacc+=pB1[r]; l_reg+=sacc;
    pw0=(u32x4){PKW(pB0,0),PKW(pB0,2),PKW(pB0,4),PKW(pB0,6)};pw1=(u32x4){PKW(pB0,8),PKW(pB0,10),PKW(pB0,12),PKW(pB0,14)};pw2=(u32x4){PKW(pB1,0),PKW(pB1,2),PKW(pB1,4),PKW(pB1,6)};pw3=(u32x4){PKW(pB1,8),PKW(pB1,10),PKW(pB1,12),PKW(pB1,14)};
    SBAR(); pv(o,vb0+sl_cur,PAF(0),PAF(1),PAF(2),PAF(3)); }
  #undef PKW
  #undef PAF
  #undef VFR
  #undef PIN
  #undef MX3
  #undef GAPA
  #undef GAPB
  #undef EX
  #undef VRD
  #undef KRD
  #undef STEP
  #undef ENDW
  {auto rr=__builtin_amdgcn_permlane32_swap(__float_as_uint(l_reg),__float_as_uint(l_reg),false,false);l_reg=__uint_as_float(rr[0])+__uint_as_float(rr[1]);}
  if(hi==0)wsf[32+r32]=l_reg;asm volatile("s_waitcnt lgkmcnt(0)":::"memory");
  float rli[16];
  #pragma unroll
  for(int r=0;r<16;++r)rli[r]=__builtin_amdgcn_rcpf(wsf[32+crow(r,hi)]);
  bf16*Ow=O+(rowbase+q0+wid*QBLK)*PO+ooff;
  { bf16*stg=(bf16*)(shm+LDS_OST)+wid*2048;
    #pragma unroll
    for(int r=0;r<16;++r){const int orow=crow(r,hi);
      #pragma unroll
      for(int d0=0;d0<2;++d0)stg[orow*64+d0*32+r32]=__float2bfloat16(o[d0][r]*rli[r]);}
    asm volatile("s_waitcnt lgkmcnt(0)":::"memory");
    #pragma unroll
    for(int i=0;i<4;++i){const int row=i*8+(lane>>3),ch=lane&7; const u32x4 v=*(const u32x4*)(stg+row*64+ch*8); ATTN_STORE16(Ow+(long)row*PO+ch*8,v);} }
  asm volatile("s_waitcnt lgkmcnt(0)\n\ts_barrier":::"memory");
  #undef DMA_K
  #undef DMA_V
  #undef CMASK
  #undef START
  #undef RESC
  #undef ROT
}
constexpr int ATTN_LDS_BYTES=LDS_BYTES;
struct AttnTensors { const bf16* Q; const bf16* K; const bf16* V; bf16* O; };
struct AttnUnit { int bh; int qb; };
struct StaticOrder {
  int vcu;
  __device__ __forceinline__ explicit StaticOrder(int grid,int block):vcu((block%8)*(grid/8)+block/8){}
  __device__ __forceinline__ bool next(int i,AttnUnit&u)const{ if(i>=4)return false; const int s=vcu&7; u.bh=vcu>>3; u.qb=(i==0)?s:(i==1)?15-s:(i==2)?16+s:31-s; return true; }
  __device__ __forceinline__ void a_ready(const AttnUnit&)const{}
  __device__ __forceinline__ void done(const AttnUnit&)const{}
};
template<class Sched,int THRL=8> __device__ __forceinline__ void attn_phase(char*lds,const AttnTensors&T,const Sched&S){
  AttnUnit u;
  for(int i=0;S.next(i,u);++i){ S.a_ready(u); const int b=u.bh/NHEAD, vh=u.bh%NHEAD, hh=vh>>2, mi=(vh>>1)&1, vj=vh&1; attn_unit<THRL>(b,hh*128+mi*64,hh*128+mi*64,hh*128+vj*64,mi*512+hh*128+vj*64,u.qb,T.Q,T.K,T.V,T.O,lds); S.done(u); }
}
#undef SBAR
#undef WAIT_BAR
}

constexpr int NWAVES = 8;
constexpr int DM = 1024, TSEQ = 8192, NBATCH = 2, MP = NBATCH * TSEQ, MS = 128, MTOT = MP + MS, MROWS = 16640;
constexpr int LW = 512, AW = 512, INW = 2560, FF = 2816, GU = 2 * FF, PLE = 256, NPAGE = 16, PAGE = 128, PASTLEN = 2048;
constexpr float LAM_INIT = 0.2f, SUBLN_SCALE = 0.8f;
constexpr float C2 = 0.125f * 1.4426950408889634f;
constexpr int CHUNK = 64, NCHUNK = MP / CHUNK;

constexpr size_t OY_P = 0, OY_S = OY_P + (size_t)MP * DM, OK_P = OY_S + (size_t)MS * DM, OV_P = OK_P + (size_t)MP * AW, OC_P = OV_P + (size_t)MP * AW,
                 OH_P = OC_P + (size_t)NBATCH * 3 * LW, OK_S = OH_P + (size_t)NBATCH * LW, OV_S = OK_S + (size_t)MS * AW, OC_S = OV_S + (size_t)MS * AW,
                 OH_S = OC_S + (size_t)MS * 3 * LW, OUT_TOTAL = OH_S + (size_t)MS * LW;
static_assert(OUT_TOTAL == 34082816, "d_out map");

constexpr size_t MiB = 1u << 20;
constexpr size_t al4k(size_t x) { return (x + 4095) & ~(size_t)4095; }
constexpr size_t WS_CTL = 0, CTL_ZERO_BYTES = 1 * MiB;
constexpr size_t WS_WIN  = 1 * MiB;
constexpr size_t WS_WOUT = WS_WIN  + al4k((size_t)INW * DM * 2);
constexpr size_t WS_WGU  = WS_WOUT + al4k((size_t)DM * DM * 2);
constexpr size_t WS_WD   = WS_WGU  + al4k((size_t)GU * DM * 2);
constexpr size_t WS_WPG  = WS_WD   + al4k((size_t)DM * FF * 2);
constexpr size_t WS_WPP  = WS_WPG  + al4k((size_t)DM * DM * 2);
constexpr size_t WS_WLRU = WS_WPP  + al4k((size_t)DM * PLE * 2);
constexpr size_t WS_ROPE = WS_WLRU + al4k((size_t)2 * 8 * 64 * 64 * 2);
constexpr size_t WS_XN   = WS_ROPE + al4k((size_t)TSEQ * 16 * 4);
constexpr size_t WS_PB   = WS_XN   + al4k((size_t)MROWS * DM * 2);
constexpr size_t WS_XL   = WS_PB   + al4k((size_t)MROWS * PLE * 2);
constexpr size_t WS_GG   = WS_XL   + al4k((size_t)MP * LW * 4);
constexpr size_t WS_Q    = WS_GG   + al4k((size_t)MP * LW * 2);
constexpr size_t WS_K    = WS_Q    + al4k((size_t)MP * AW * 2);
constexpr size_t WS_V    = WS_K    + al4k((size_t)MP * AW * 2);
constexpr size_t WS_O    = WS_V    + al4k((size_t)MP * AW * 2);
constexpr size_t WS_HL   = WS_O    + al4k((size_t)MP * 2 * AW * 2);
constexpr size_t WS_PC   = WS_HL   + al4k((size_t)MP * LW * 4);
constexpr size_t WS_CHS  = WS_PC   + al4k((size_t)MP * LW * 4);
constexpr size_t WS_AMIX = WS_CHS  + al4k((size_t)NCHUNK * 2 * LW * 4);
constexpr size_t WS_MIX  = WS_AMIX + al4k((size_t)MROWS * DM * 2);
constexpr size_t WS_X1   = WS_MIX  + al4k((size_t)MROWS * DM * 4);
constexpr size_t WS_HB   = WS_X1   + al4k((size_t)MROWS * DM * 4);
constexpr size_t WS_PROJ = WS_HB   + al4k((size_t)MP * FF * 2);
constexpr size_t WS_US   = WS_PROJ + al4k((size_t)MP * DM * 2);
constexpr size_t WS_GUS  = WS_US   + al4k((size_t)MS * INW * 4);
constexpr size_t WS_GS   = WS_GUS  + al4k((size_t)MS * GU * 4);
constexpr size_t WS_PJS  = WS_GS   + al4k((size_t)MS * DM * 4);
constexpr size_t WS_QS   = WS_PJS  + al4k((size_t)MS * DM * 4);
constexpr size_t DP_STRIDE = 2 * 132;
constexpr size_t WS_DP   = WS_QS   + al4k((size_t)MS * AW * 4);
constexpr size_t WS_END  = WS_DP   + al4k((size_t)MS * 2 * 4 * DP_STRIDE * 4);
constexpr int CW_TMO = 0, CW_CODE = 1, CW_DBG = 64;
constexpr int CW_BAR = 4096;

constexpr int RING_OFF = 0, RING_BYTES = 131072;
constexpr int LDSCTL_OFF = RING_BYTES, MISC_OFF = LDSCTL_OFF + 320;
constexpr int LDS_BYTES = 147456;
static_assert(MISC_OFF + 128 <= LDS_BYTES, "LDS map");

#define GAS __attribute__((address_space(1)))
#define LAS __attribute__((address_space(3)))
typedef unsigned short bf16;
typedef unsigned v4u __attribute__((ext_vector_type(4)));
typedef float f32x4 __attribute__((ext_vector_type(4)));
typedef short bf16x8 __attribute__((ext_vector_type(8)));
typedef GAS unsigned gu32;
typedef GAS unsigned long long gu64;
#define RLX_AGENT __ATOMIC_RELAXED, __HIP_MEMORY_SCOPE_AGENT
#define LDS_WAIT() asm volatile("s_waitcnt lgkmcnt(0)" ::: "memory")
#define VM_WAIT() asm volatile("s_waitcnt vmcnt(0)" ::: "memory")
__device__ __forceinline__ unsigned long long rt() { return __builtin_amdgcn_s_memrealtime(); }
__device__ __forceinline__ unsigned f2bf(float f) { unsigned u = __builtin_bit_cast(unsigned, f); return (u + 0x7fffu + ((u >> 16) & 1u)) >> 16; }
__device__ __forceinline__ unsigned pk2(float lo, float hi) { return f2bf(lo) | (f2bf(hi) << 16); }

#define XB_TMO      128
#define XB_XCNT(j)  (256  + 64 * (j))
#define XB_XSUB(j)  (1280 + 64 * (j))
#define XB_XGEN(j)  (2304 + 64 * (j))
#define XB_TOP      3328
#define XB_TOPGEN   3392
#define XCD_BAR_WORDS 3456
#define XB_SPIN_CAP (1u << 18)

__device__ __forceinline__ unsigned xb_ld(unsigned* p)              { return __hip_atomic_load(p, __ATOMIC_RELAXED, __HIP_MEMORY_SCOPE_AGENT); }
__device__ __forceinline__ unsigned xb_add(unsigned* p, unsigned v) { return __hip_atomic_fetch_add(p, v, __ATOMIC_RELAXED, __HIP_MEMORY_SCOPE_AGENT); }
__device__ __forceinline__ unsigned xb_xcc_id() { return (unsigned)__builtin_amdgcn_s_getreg((3 << 11) | 20) & 0xFu; }
#define XB_SPIN(cond, bar) do { unsigned _sp = 0; while (cond) { __builtin_amdgcn_s_sleep(1); \
    if ((++_sp & 255u) == 0u) { if (xb_ld(&(bar)[XB_TMO])) break; if (_sp > XB_SPIN_CAP) { atomicAdd(&(bar)[XB_TMO], 1u); break; } } } } while (0)

struct XcdBarrier {
    unsigned* bar; unsigned x;
    volatile LAS unsigned* st;
};

__device__ __forceinline__ XcdBarrier xcd_barrier_post(unsigned* bar, volatile LAS unsigned* st) {
    XcdBarrier b; b.bar = bar; b.x = xb_xcc_id(); b.st = st;
    if (threadIdx.x == 0) (void)xb_add(&bar[XB_XCNT(b.x)], 1u);
    return b;
}
__device__ __forceinline__ void xcd_barrier_complete(unsigned* bar, unsigned x, unsigned& nloc, unsigned& nx) {
    const unsigned G = gridDim.x * gridDim.y * gridDim.z;
    unsigned sum, cnt, mine, sp = 0u;
    for (;;) {
        sum = 0u; cnt = 0u; mine = 0u;
#pragma unroll
        for (unsigned j = 0; j < 16; ++j) { const unsigned c = xb_ld(&bar[XB_XCNT(j)]); sum += c; cnt += (c > 0u) ? 1u : 0u; mine = (j == x) ? c : mine; }
        if (sum == G) break;
        __builtin_amdgcn_s_sleep(1);
        if ((++sp & 255u) == 0u) { if (xb_ld(&bar[XB_TMO])) break; if (sp > XB_SPIN_CAP) { atomicAdd(&bar[XB_TMO], 1u); break; } }
    }
    nloc = mine > 0u ? mine : 1u; nx = cnt > 0u ? cnt : 1u;
}

__device__ __forceinline__ void xcd_barrier(const XcdBarrier& b) {
    asm volatile("s_waitcnt vmcnt(0)" ::: "memory");
    __syncthreads();
    if (threadIdx.x == 0) {
        unsigned* bar = b.bar;
        __builtin_amdgcn_s_waitcnt(0);
        unsigned nloc = b.st[0], nx = b.st[1];
        if (nloc == 0u) { xcd_barrier_complete(bar, b.x, nloc, nx); b.st[0] = nloc; b.st[1] = nx; }
        const unsigned old = xb_add(&bar[XB_XSUB(b.x)], 1u);
        const unsigned gen = old / nloc;
        if (old + 1u == (gen + 1u) * nloc) {
            __builtin_amdgcn_fence(__ATOMIC_RELEASE, "agent");
            asm volatile("s_waitcnt vmcnt(0)" ::: "memory");
            const unsigned og = xb_add(&bar[XB_TOP], 1u);
            const unsigned tg = og / nx;
            if (og + 1u == (tg + 1u) * nx) xb_add(&bar[XB_TOPGEN], 1u);
            else XB_SPIN(xb_ld(&bar[XB_TOPGEN]) == tg, bar);
            __builtin_amdgcn_fence(__ATOMIC_ACQUIRE, "agent");
            xb_add(&bar[XB_XGEN(b.x)], 1u);
            asm volatile("s_waitcnt vmcnt(0)" ::: "memory");
        } else {
            XB_SPIN(xb_ld(&bar[XB_XGEN(b.x)]) == gen, bar);
            __builtin_amdgcn_fence(__ATOMIC_ACQUIRE, "agent");
            asm volatile("s_waitcnt vmcnt(0)" ::: "memory");
        }
    }
    __syncthreads();
}

typedef float f32x2g __attribute__((ext_vector_type(2)));
typedef unsigned u32x2g __attribute__((ext_vector_type(2)));
struct Frame {
    LAS unsigned char* lds;
    volatile LAS unsigned* MISC;
    gu32* ctl;
    int wave;
    int vcu, G;
    unsigned char* ws; float* out;

};
__device__ __forceinline__ float wave_sum(float v) {
#pragma unroll
    for (int o = 1; o < 64; o <<= 1) v += __shfl_xor(v, o);
    return v;
}
__device__ __forceinline__ float sigmoidf_(float x) { return __builtin_amdgcn_rcpf(1.f + __builtin_amdgcn_exp2f(-1.4426950408889634f * x)); }
__device__ __forceinline__ float gelu_tanh_(float x) { const float u = 1.5957691216057308f * (x + 0.044715f * x * x * x); return x * __builtin_amdgcn_rcpf(1.f + __builtin_amdgcn_exp2f(-1.4426950408889634f * u)); }
__device__ __forceinline__ float bf2f(unsigned short h) { return __builtin_bit_cast(float, (unsigned)h << 16); }

struct EpiIn {
    static constexpr bool PERM = true, AFTER_DRAIN = false;
    float* XL; bf16* GG; bf16* Q; bf16* K; bf16* V; float* kout; float* vout; const float* rope;
    __device__ __forceinline__ void operator()(const pg8::f32x4 (&acc)[2][2][4][2], const pg8::Unit& u, int wr, int wc, int fr, int fq) const {
        const int sec = u.pn >> 1;
        const int row0 = u.pm * 256 + wr * 64 + fr;
        const int cbase = (u.pn & 1) * 256 + wc * 32 + 8 * fq;
#pragma unroll
        for (int ai = 0; ai < 2; ++ai)
#pragma unroll
            for (int m = 0; m < 4; ++m) {
                const int row = row0 + ai * 128 + m * 16;
                f32x4 rc0, rc1, rs0, rs1;
                if ((sec == 2 || sec == 3) && !(wc & 1)) { const f32x4* rp = (const f32x4*)(rope + (size_t)(row & (TSEQ - 1)) * 16); rc0 = rp[0]; rc1 = rp[1]; rs0 = rp[2]; rs1 = rp[3]; }
#pragma unroll
                for (int bj = 0; bj < 2; ++bj) {
                    const int cs = cbase + bj * 128;
                    f32x4 v0 = acc[ai][bj][m][0], v1 = acc[ai][bj][m][1];
                    const size_t o = (size_t)row * 512 + cs;
                    if (sec == 0) { *(f32x4*)(XL + o) = v0; *(f32x4*)(XL + o + 4) = v1; }
                    else if (sec == 1) {
                        v4u w; w.x = pk2(gelu_tanh_(v0[0]), gelu_tanh_(v0[1])); w.y = pk2(gelu_tanh_(v0[2]), gelu_tanh_(v0[3])); w.z = pk2(gelu_tanh_(v1[0]), gelu_tanh_(v1[1])); w.w = pk2(gelu_tanh_(v1[2]), gelu_tanh_(v1[3]));
                        *(v4u*)(GG + o) = w; }
                    else {
                        if (sec != 4 && !(wc & 1)) {
                            f32x4 p0, p1;
#pragma unroll
                            for (int e = 0; e < 4; ++e) { p0[e] = __shfl_xor(v0[e], 16); p1[e] = __shfl_xor(v1[e], 16); }
                            if (fq == 0) { v0 = v0 * rc0 - p0 * rs0; v1 = v1 * rc1 - p1 * rs1; }
                            else if (fq == 1) { v0 = v0 * rc0 + p0 * rs0; v1 = v1 * rc1 + p1 * rs1; }
                        }
                        if (sec == 2) { v0 = v0 * C2; v1 = v1 * C2; v4u w; w.x = pk2(v0[0], v0[1]); w.y = pk2(v0[2], v0[3]); w.z = pk2(v1[0], v1[1]); w.w = pk2(v1[2], v1[3]); *(v4u*)(Q + o) = w; }
                        else { float* fo = (sec == 3 ? kout : vout) + o; *(f32x4*)fo = v0; *(f32x4*)(fo + 4) = v1;
                            v4u w; w.x = pk2(v0[0], v0[1]); w.y = pk2(v0[2], v0[3]); w.z = pk2(v1[0], v1[1]); w.w = pk2(v1[2], v1[3]); *(v4u*)((sec == 3 ? K : V) + o) = w; }
                    }
                }
            }
    }
};
struct EpiBf {
    static constexpr bool PERM = true, AFTER_DRAIN = false;
    bf16* O; int ldc;
    __device__ __forceinline__ void operator()(const pg8::f32x4 (&acc)[2][2][4][2], const pg8::Unit& u, int wr, int wc, int fr, int fq) const {
        const int row0 = u.pm * 256 + wr * 64 + fr, col0 = u.pn * 256 + wc * 32 + 8 * fq;
#pragma unroll
        for (int ai = 0; ai < 2; ++ai)
#pragma unroll
            for (int m = 0; m < 4; ++m)
#pragma unroll
                for (int bj = 0; bj < 2; ++bj) { const f32x4 v0 = acc[ai][bj][m][0], v1 = acc[ai][bj][m][1];
                    v4u w; w.x = pk2(v0[0], v0[1]); w.y = pk2(v0[2], v0[3]); w.z = pk2(v1[0], v1[1]); w.w = pk2(v1[2], v1[3]);
                    *(v4u*)(O + (size_t)(row0 + ai * 128 + m * 16) * ldc + col0 + bj * 128) = w; }
    }
};
struct EpiF32 {
    static constexpr bool PERM = true, AFTER_DRAIN = false;
    float* O; int ldc;
    __device__ __forceinline__ void operator()(const pg8::f32x4 (&acc)[2][2][4][2], const pg8::Unit& u, int wr, int wc, int fr, int fq) const {
        const int row0 = u.pm * 256 + wr * 64 + fr, col0 = u.pn * 256 + wc * 32 + 8 * fq;
#pragma unroll
        for (int ai = 0; ai < 2; ++ai)
#pragma unroll
            for (int m = 0; m < 4; ++m)
#pragma unroll
                for (int bj = 0; bj < 2; ++bj) { float* p = O + (size_t)(row0 + ai * 128 + m * 16) * ldc + col0 + bj * 128; *(f32x4*)p = acc[ai][bj][m][0]; *(f32x4*)(p + 4) = acc[ai][bj][m][1]; }
    }
};
struct EpiSwiGlu {
    static constexpr bool PERM = true, AFTER_DRAIN = false;
    bf16* H;
    __device__ __forceinline__ void operator()(const pg8::f32x4 (&acc)[2][2][4][2], const pg8::Unit& u, int wr, int wc, int fr, int fq) const {
        const int row0 = u.pm * 256 + wr * 64 + fr, col0 = u.pn * 128 + wc * 32 + 8 * fq;
#pragma unroll
        for (int ai = 0; ai < 2; ++ai)
#pragma unroll
            for (int m = 0; m < 4; ++m) { const f32x4 g0 = acc[ai][0][m][0], g1 = acc[ai][0][m][1], u0 = acc[ai][1][m][0], u1 = acc[ai][1][m][1]; float h[8];
#pragma unroll
                for (int e = 0; e < 4; ++e) { h[e] = g0[e] * sigmoidf_(g0[e]) * u0[e]; h[4 + e] = g1[e] * sigmoidf_(g1[e]) * u1[e]; }
                v4u w; w.x = pk2(h[0], h[1]); w.y = pk2(h[2], h[3]); w.z = pk2(h[4], h[5]); w.w = pk2(h[6], h[7]);
                *(v4u*)(H + (size_t)(row0 + ai * 128 + m * 16) * FF + col0) = w; }
    }
};
struct EpiPle {
    static constexpr bool PERM = true, AFTER_DRAIN = false;
    const bf16* P; float* O;
    __device__ __forceinline__ void operator()(const pg8::f32x4 (&acc)[2][2][4][2], const pg8::Unit& u, int wr, int wc, int fr, int fq) const {
        const int row0 = u.pm * 256 + wr * 64 + fr, col0 = u.pn * 256 + wc * 32 + 8 * fq;
#pragma unroll
        for (int ai = 0; ai < 2; ++ai)
#pragma unroll
            for (int m = 0; m < 4; ++m)
#pragma unroll
                for (int bj = 0; bj < 2; ++bj) { const size_t o = (size_t)(row0 + ai * 128 + m * 16) * DM + col0 + bj * 128; const v4u pw = *(const v4u*)(P + o);
                    const f32x4 v0 = acc[ai][bj][m][0], v1 = acc[ai][bj][m][1]; f32x4 r0, r1;
                    r0[0] = sigmoidf_(v0[0]) * bf2f((unsigned short)(pw.x & 0xffff)); r0[1] = sigmoidf_(v0[1]) * bf2f((unsigned short)(pw.x >> 16));
                    r0[2] = sigmoidf_(v0[2]) * bf2f((unsigned short)(pw.y & 0xffff)); r0[3] = sigmoidf_(v0[3]) * bf2f((unsigned short)(pw.y >> 16));
                    r1[0] = sigmoidf_(v1[0]) * bf2f((unsigned short)(pw.z & 0xffff)); r1[1] = sigmoidf_(v1[1]) * bf2f((unsigned short)(pw.z >> 16));
                    r1[2] = sigmoidf_(v1[2]) * bf2f((unsigned short)(pw.w & 0xffff)); r1[3] = sigmoidf_(v1[3]) * bf2f((unsigned short)(pw.w >> 16));
                    *(f32x4*)(O + o) = r0; *(f32x4*)(O + o + 4) = r1; }
    }
};

template <int AMODE> __device__ __forceinline__ bf16x8 sg_load_a(const void* A, int lda, int row, int k) {
    if constexpr (AMODE == 0) { return *(const bf16x8*)((const bf16*)A + (size_t)row * lda + k); }
    else { const float* g = (const float*)A + (size_t)row * GU + (k >> 7) * 256 + (k & 127); const f32x4 g0 = *(const f32x4*)g, g1 = *(const f32x4*)(g + 4), u0 = *(const f32x4*)(g + 128), u1 = *(const f32x4*)(g + 132);
        v4u w; w.x = pk2(g0[0] * sigmoidf_(g0[0]) * u0[0], g0[1] * sigmoidf_(g0[1]) * u0[1]); w.y = pk2(g0[2] * sigmoidf_(g0[2]) * u0[2], g0[3] * sigmoidf_(g0[3]) * u0[3]);
        w.z = pk2(g1[0] * sigmoidf_(g1[0]) * u1[0], g1[1] * sigmoidf_(g1[1]) * u1[1]); w.w = pk2(g1[2] * sigmoidf_(g1[2]) * u1[2], g1[3] * sigmoidf_(g1[3]) * u1[3]);
        return __builtin_bit_cast(bf16x8, w); }
}
template <int AMODE> __device__ __forceinline__ void small_gemm(Frame& F, const void* A, int lda, const bf16* Bt, int N, int K, float* C, int ldc) {
    LAS float* part = (LAS float*)(F.lds + RING_OFF);
    const int lane = lane_now(), tid = F.wave * 64 + lane, w = F.wave, fr = lane & 15, fq = lane >> 4;
    const int nitems = 8 * (N / 32), kw = K / 8;
    for (int it = F.G - 1 - (int)blockIdx.x; it < nitems; it += F.G) {
        const int row0 = (it & 7) * 16, col0 = (it >> 3) * 32;
        f32x4 acc0 = {0.f, 0.f, 0.f, 0.f}, acc1 = {0.f, 0.f, 0.f, 0.f};
        const int kbeg = w * kw;
        const bf16* b0p = Bt + (size_t)(col0 + fr) * K + 8 * fq; const bf16* b1p = b0p + (size_t)16 * K;
#pragma unroll 4
        for (int k = kbeg; k < kbeg + kw; k += 32) {
            const bf16x8 a = sg_load_a<AMODE>(A, lda, row0 + fr, k + 8 * fq);
            const bf16x8 b0 = *(const bf16x8*)(b0p + k), b1 = *(const bf16x8*)(b1p + k);
            acc0 = __builtin_amdgcn_mfma_f32_16x16x32_bf16(a, b0, acc0, 0, 0, 0);
            acc1 = __builtin_amdgcn_mfma_f32_16x16x32_bf16(a, b1, acc1, 0, 0, 0);
        }
#pragma unroll
        for (int r = 0; r < 4; ++r) { part[((w * 2 + 0) * 4 + r) * 64 + lane] = acc0[r]; part[((w * 2 + 1) * 4 + r) * 64 + lane] = acc1[r]; }
        __syncthreads();
        { const int r = tid >> 5, n = tid & 31, c = n >> 4, ln = (n & 15) + 16 * (r >> 2), rg = r & 3; float s = 0.f;
#pragma unroll
          for (int w2 = 0; w2 < 8; ++w2) s += part[((w2 * 2 + c) * 4 + rg) * 64 + ln];
          C[(size_t)(row0 + r) * ldc + col0 + n] = s; }
        __syncthreads();
    }
}

__device__ __forceinline__ void p0_transpose_item(const float* W, int N, bf16* WT, int ldt, int k0, int n0, int dst_row, LAS float* scr, int lane) {
#pragma unroll 8
    for (int i = 0; i < 32; ++i) { const int kk = 2 * i + (lane >> 5); scr[kk * 33 + (lane & 31)] = W[(size_t)(k0 + kk) * N + n0 + (lane & 31)]; }
    LDS_WAIT(); asm volatile("" ::: "memory");
    const int c = lane & 7;
#pragma unroll
    for (int j = 0; j < 4; ++j) { const int n = (lane >> 3) + 8 * j; const LAS float* s = scr + (8 * c) * 33 + n;
        v4u o; o.x = pk2(s[0 * 33], s[1 * 33]); o.y = pk2(s[2 * 33], s[3 * 33]); o.z = pk2(s[4 * 33], s[5 * 33]); o.w = pk2(s[6 * 33], s[7 * 33]);
        *(GAS v4u*)(WT + (size_t)(dst_row + n) * ldt + k0 + 8 * c) = o; }
    LDS_WAIT(); asm volatile("" ::: "memory");
}
__device__ __forceinline__ void row_load(const float* xrow, int lane, f32x4 (&v)[4]) {
    const GAS f32x4* xr = (const GAS f32x4*)xrow + lane;
#pragma unroll
    for (int j = 0; j < 4; ++j) v[j] = xr[64 * j];
}
__device__ __forceinline__ float row_ssq(const f32x4 (&v)[4]) { float s = 0.f;
#pragma unroll
    for (int j = 0; j < 4; ++j) s += (v[j].x * v[j].x + v[j].y * v[j].y) + (v[j].z * v[j].z + v[j].w * v[j].w);
    return wave_sum(s); }
__device__ __forceinline__ void row_store_bf16(bf16* orow, int lane, const f32x4 (&v)[4]) {
    GAS unsigned long long* o8 = (GAS unsigned long long*)orow + lane;
#pragma unroll
    for (int j = 0; j < 4; ++j) o8[64 * j] = (unsigned long long)pk2(v[j].x, v[j].y) | ((unsigned long long)pk2(v[j].z, v[j].w) << 32);
}
__device__ __forceinline__ void row_store_f32(float* orow, int lane, const f32x4 (&v)[4]) {
    GAS f32x4* o = (GAS f32x4*)orow + lane;
#pragma unroll
    for (int j = 0; j < 4; ++j) o[64 * j] = v[j];
}

struct LruArgs {
    const float* XL; const float* conv_w; const float* conv_b; const bf16* WL; const float* ba; const float* bx; const float* Lp;
    float* HL; float* PC; float* CHS;
    const float* US; const float* sconv; const float* sh; float* hout; bf16* amix;
};
constexpr int LRU_XT = 19 * 64, LRU_AT = 16 * 64 / 2, LRU_G = 16 * 65, LRU_WAVE_F = LRU_XT + LRU_AT + 2 * LRU_G;
static_assert(LRU_WAVE_F * 4 * 8 <= RING_BYTES, "LRU LDS");
__device__ __forceinline__ float expm1_neg_(float x) {
    const float t = x * (1.f + x * (0.5f + x * (0.16666667f + x * (0.041666668f + x * (0.0083333338f + x * 0.0013888889f)))));
    const float e = __builtin_amdgcn_exp2f(x * 1.4426950408889634f) - 1.f;
    return x > -0.3f ? t : e;
}
template <bool SAMPLE> __device__ __forceinline__ void lru_unit(Frame& F, const LruArgs& A, int unit) {
    const int lane = lane_now(), n = F.wave, i16 = lane & 15, kq = lane >> 4;
    LAS float* XT = (LAS float*)(F.lds + RING_OFF) + n * LRU_WAVE_F;
    LAS unsigned short* AT = (LAS unsigned short*)(XT + LRU_XT);
    LAS float* RR = XT + LRU_XT + LRU_AT; LAS float* IG = RR + LRU_G;
    bf16x8 bR[4][2], bI[4][2];
#pragma unroll
    for (int nt = 0; nt < 4; ++nt)
#pragma unroll
        for (int ks = 0; ks < 2; ++ks) { const size_t o = (size_t)n * 4096 + (size_t)(16 * nt + i16) * 64 + 32 * ks + 8 * kq; bR[nt][ks] = *(const bf16x8*)(A.WL + o); bI[nt][ks] = *(const bf16x8*)(A.WL + 32768 + o); }
    float bar_[4], bxr_[4];
#pragma unroll
    for (int nt = 0; nt < 4; ++nt) { bar_[nt] = A.ba[64 * n + 16 * nt + i16]; bxr_[nt] = A.bx[64 * n + 16 * nt + i16]; }
    const int chl = 64 * n + lane;
    const float sp8 = -8.f * log1pf(expf(-A.Lp[chl]));
    const float cw0 = A.conv_w[chl], cw1 = A.conv_w[LW + chl], cw2 = A.conv_w[2 * LW + chl], cw3 = A.conv_w[3 * LW + chl], cb = A.conv_b[chl];
    float hl = 0.f, pc = 1.f;
    constexpr int NSTEP = SAMPLE ? 1 : 4;
    const int r0 = unit * (SAMPLE ? 16 : 64);
    const int t0 = SAMPLE ? 0 : (r0 & (TSEQ - 1));
    f32x4 xs[5];
    auto xt_load = [&](int mt) {
#pragma unroll
        for (int j = 0; j < 5; ++j) { const int p = lane + 64 * j, rw = p >> 4, c4 = p & 15; const int tr = 16 * mt - 3 + rw;
            if (p < 304 && t0 + tr >= 0) xs[j] = *(const f32x4*)(A.XL + (size_t)(r0 + tr) * LW + 64 * n + 4 * c4); else xs[j] = (f32x4){0.f, 0.f, 0.f, 0.f}; } };
    if (!SAMPLE) xt_load(0);
    for (int mt = 0; mt < NSTEP; ++mt) {
        float xc[16];
        if (SAMPLE) {
            float xv[16][4];
#pragma unroll
            for (int t = 0; t < 16; ++t) { const int b = r0 + t;
                xv[t][0] = A.sconv[((size_t)b * 3 + 0) * LW + chl]; xv[t][1] = A.sconv[((size_t)b * 3 + 1) * LW + chl]; xv[t][2] = A.sconv[((size_t)b * 3 + 2) * LW + chl]; xv[t][3] = A.US[(size_t)b * INW + chl]; }
#pragma unroll
            for (int t = 0; t < 16; ++t) xc[t] = cb + cw0 * xv[t][0] + cw1 * xv[t][1] + cw2 * xv[t][2] + cw3 * xv[t][3];
        } else {
#pragma unroll
            for (int j = 0; j < 5; ++j) { const int p = lane + 64 * j; if (p < 304) *(LAS f32x4*)(XT + (p >> 4) * 64 + 4 * (p & 15)) = xs[j]; }
            LDS_WAIT(); asm volatile("" ::: "memory");
            if (mt + 1 < NSTEP) xt_load(mt + 1);
#pragma unroll
            for (int t = 0; t < 16; ++t) xc[t] = cb + cw0 * XT[t * 64 + lane] + cw1 * XT[(t + 1) * 64 + lane] + cw2 * XT[(t + 2) * 64 + lane] + cw3 * XT[(t + 3) * 64 + lane];
        }
#pragma unroll
        for (int t = 0; t < 16; ++t) AT[t * 64 + lane] = (unsigned short)f2bf(xc[t]);
        LDS_WAIT(); asm volatile("" ::: "memory");
        bf16x8 afr[2];
#pragma unroll
        for (int ks = 0; ks < 2; ++ks) afr[ks] = *(const LAS bf16x8*)(AT + i16 * 64 + 32 * ks + 8 * kq);
#pragma unroll
        for (int nt = 0; nt < 4; ++nt) {
            f32x4 aR = {0.f, 0.f, 0.f, 0.f}, aI = {0.f, 0.f, 0.f, 0.f};
#pragma unroll
            for (int ks = 0; ks < 2; ++ks) { aR = __builtin_amdgcn_mfma_f32_16x16x32_bf16(afr[ks], bR[nt][ks], aR, 0, 0, 0); aI = __builtin_amdgcn_mfma_f32_16x16x32_bf16(afr[ks], bI[nt][ks], aI, 0, 0, 0); }
#pragma unroll
            for (int r = 0; r < 4; ++r) { RR[(4 * kq + r) * 65 + 16 * nt + i16] = sigmoidf_(aR[r] + bar_[nt]); IG[(4 * kq + r) * 65 + 16 * nt + i16] = sigmoidf_(aI[r] + bxr_[nt]); }
        }
        LDS_WAIT(); asm volatile("" ::: "memory");
#pragma unroll
        for (int tl = 0; tl < 16; ++tl) {
            const float rr = RR[tl * 65 + lane], gg = IG[tl * 65 + lane];
            const float la = rr * sp8, a = __builtin_amdgcn_exp2f(la * 1.4426950408889634f), bt = __builtin_amdgcn_sqrtf(-expm1_neg_(2.f * la)) * (gg * xc[tl]);
            const int row = r0 + 16 * mt + tl;
            if (SAMPLE) { const float h = a * A.sh[(size_t)row * LW + chl] + bt; A.hout[(size_t)row * LW + chl] = h;
                const float g = A.US[(size_t)row * INW + LW + chl]; A.amix[(size_t)(MP + row) * DM + chl] = (bf16)f2bf(h * gelu_tanh_(g)); }
            else { hl = a * hl + bt; pc *= a; A.HL[(size_t)row * LW + chl] = hl; A.PC[(size_t)row * LW + chl] = pc; }
        }
        LDS_WAIT(); asm volatile("" ::: "memory");
    }
    if (!SAMPLE) { A.CHS[(size_t)unit * 2 * LW + chl] = pc; A.CHS[(size_t)unit * 2 * LW + LW + chl] = hl; }
}

struct DecArgs { const float* US; const float* rope; const float* ck; const float* cv; const int* pt; float* ksout; float* vsout; float* QS; float* DP; };
__device__ __forceinline__ float row16_sum(float v) {
    v += __shfl_xor(v, 1); v += __shfl_xor(v, 2); v += __shfl_xor(v, 4); v += __shfl_xor(v, 8); return v;
}
__device__ __forceinline__ void decode_unit(Frame& F, const DecArgs& A, int b, int split) {
    LAS float* qs = (LAS float*)(F.lds + RING_OFF);
    LAS float* racc = qs + 512;
    LAS float* rml = racc + 8 * 8 * 64;
    const int lane = lane_now();
    { const int cs = F.wave * 64 + lane, d = cs & 63; const float* ub = A.US + (size_t)b * INW;
      float qv = ub[1024 + cs], kv = ub[1536 + cs];
      if (d < 16) { const int i = d & 7, pc = d < 8 ? cs + 8 : cs - 8; const float c = A.rope[(size_t)PASTLEN * 16 + i], s = A.rope[(size_t)PASTLEN * 16 + 8 + i];
          const float qp = ub[1024 + pc], kp = ub[1536 + pc];
          if (d < 8) { qv = qv * c - qp * s; kv = kv * c - kp * s; } else { qv = qv * c + qp * s; kv = kv * c + kp * s; } }
      qs[cs] = qv * C2;
      if (split == 0) { A.QS[(size_t)b * AW + cs] = qv * C2; A.ksout[(size_t)b * AW + cs] = kv; A.vsout[(size_t)b * AW + cs] = ub[2048 + cs]; } }
    __syncthreads();
    const int w = F.wave, hp = w & 1, sub = w >> 1;
    const int head = 2 * hp + (lane >> 5), e4 = 4 * (lane & 31);
    const bool map0 = ((lane >> 4) & 1) == 0;
    const f32x4 q = *(const LAS f32x4*)(qs + head * 128 + e4);
    float m = -1e30f, l = 0.f; f32x4 a1 = {0.f, 0.f, 0.f, 0.f}, a2 = {0.f, 0.f, 0.f, 0.f};
    for (int pg = 0; pg < 2; ++pg) {
        const int page = __builtin_amdgcn_readfirstlane(A.pt[b * NPAGE + split * 8 + sub * 2 + pg]);
        const float* kb = A.ck + (size_t)page * (PAGE * 512) + head * 128 + e4;
        const float* vb = A.cv + (size_t)page * (PAGE * 512) + head * 128 + e4;
        for (int s0 = 0; s0 < PAGE; s0 += 8) {
            f32x4 kk[8], vv[8];
#pragma unroll
            for (int j = 0; j < 8; ++j) { kk[j] = __builtin_nontemporal_load((const f32x4*)(kb + (size_t)(s0 + j) * 512)); vv[j] = __builtin_nontemporal_load((const f32x4*)(vb + (size_t)(s0 + j) * 512)); }
            float sc[8]; float mx = -1e30f;
#pragma unroll
            for (int j = 0; j < 8; ++j) { sc[j] = row16_sum((q[0] * kk[j][0] + q[1] * kk[j][1]) + (q[2] * kk[j][2] + q[3] * kk[j][3])); mx = fmaxf(mx, sc[j]); }
            const float mn = fmaxf(m, mx), corr = __builtin_amdgcn_exp2f(m - mn); m = mn;
            float p[8], ps = 0.f;
#pragma unroll
            for (int j = 0; j < 8; ++j) { p[j] = __builtin_amdgcn_exp2f(sc[j] - mn); ps += p[j]; }
            l = l * corr + ps;
            const float corr_o = __shfl_xor(corr, 16);
            const float c1 = map0 ? corr : corr_o, c2 = map0 ? corr_o : corr;
            a1 = a1 * c1; a2 = a2 * c2;
#pragma unroll
            for (int j = 0; j < 8; ++j) { const float po = __shfl_xor(p[j], 16); const float p1 = map0 ? p[j] : po, p2 = map0 ? po : p[j]; a1 += vv[j] * p1; a2 += vv[j] * p2; }
        }
    }
#pragma unroll
    for (int e = 0; e < 4; ++e) { racc[(w * 8 + e) * 64 + lane] = a1[e]; racc[(w * 8 + 4 + e) * 64 + lane] = a2[e]; }
    rml[(w * 2 + 0) * 64 + lane] = m; rml[(w * 2 + 1) * 64 + lane] = l;
    __syncthreads();
    if (w < 2) {
        const int l1 = lane & ~16, l2 = lane | 16;
        float M1 = -1e30f, M2 = -1e30f;
#pragma unroll
        for (int s = 0; s < 4; ++s) { const int wv = hp + 2 * s; M1 = fmaxf(M1, rml[(wv * 2) * 64 + l1]); M2 = fmaxf(M2, rml[(wv * 2) * 64 + l2]); }
        float L1 = 0.f, L2 = 0.f; f32x4 o1 = {0.f, 0.f, 0.f, 0.f}, o2 = {0.f, 0.f, 0.f, 0.f};
#pragma unroll
        for (int s = 0; s < 4; ++s) { const int wv = hp + 2 * s;
            const float w1 = __builtin_amdgcn_exp2f(rml[(wv * 2) * 64 + l1] - M1), w2 = __builtin_amdgcn_exp2f(rml[(wv * 2) * 64 + l2] - M2);
            L1 += rml[(wv * 2 + 1) * 64 + l1] * w1; L2 += rml[(wv * 2 + 1) * 64 + l2] * w2;
#pragma unroll
            for (int e = 0; e < 4; ++e) { o1[e] += racc[(wv * 8 + e) * 64 + lane] * w1; o2[e] += racc[(wv * 8 + 4 + e) * 64 + lane] * w2; } }
        float* dp = A.DP + ((size_t)(b * 2 + split) * 4 + head) * DP_STRIDE;
        *(f32x4*)(dp + e4) = o1; *(f32x4*)(dp + 132 + e4) = o2;
        if ((lane & 31) == 0) { dp[128] = M1; dp[129] = L1; dp[132 + 128] = M2; dp[132 + 129] = L2; }
    }
    __syncthreads();
}


#ifndef MK_N_LAUNCHES
#define MK_N_LAUNCHES 1
#endif
constexpr int N_PHASES = 11;
#ifndef REP_P0
#define REP_P0 1
#endif
#ifndef REP_P3
#define REP_P3 1
#endif
#ifndef REP_P5
#define REP_P5 1
#endif
#ifndef REP_P10
#define REP_P10 1
#endif
#ifndef REP_LRU
#define REP_LRU 1
#endif
struct Args { const void* in[33]; float* out; unsigned char* ws; float inv_freq[8]; int ph_lo, ph_hi, li, pad; };
enum { I_XP = 0, I_XS, I_CK, I_CV, I_SCONV, I_SH, I_PT, I_PP, I_PS, I_NPM, I_WIN, I_CONVW, I_CONVB, I_WA, I_BA, I_WX, I_BX, I_L, I_LQ1, I_LK1, I_LQ2, I_LK2, I_SUBG, I_WOUT, I_NPOSTM, I_NPREF,
       I_WG, I_WU, I_WD, I_NPOSTF, I_PWG, I_PWP, I_PNORM };

__global__ void __launch_bounds__(NWAVES * 64, 2) hymba_fwd(Args args) {
    extern __shared__ __attribute__((aligned(16))) unsigned char lds[];
    Frame F;
    F.lds = (LAS unsigned char*)lds;
    F.MISC = (volatile LAS unsigned*)(F.lds + MISC_OFF);
    F.wave = __builtin_amdgcn_readfirstlane((int)threadIdx.x >> 6);
    F.G = gridDim.x; { const int bx = blockIdx.x; F.vcu = (F.G % 8 == 0) ? (bx % 8) * (F.G / 8) + bx / 8 : bx; }
    F.ctl = (gu32*)(args.ws + WS_CTL);
#define INF(k) ((const float*)args.in[k])
#define WSB(off) ((bf16*)(args.ws + (off)))
#define WSF(off) ((float*)(args.ws + (off)))
#define WIN WSB(WS_WIN)
#define WOUT WSB(WS_WOUT)
#define WGU WSB(WS_WGU)
#define WD WSB(WS_WD)
#define WPG WSB(WS_WPG)
#define WPP WSB(WS_WPP)
#define WLRU WSB(WS_WLRU)
#define ROPE WSF(WS_ROPE)
#define XN WSB(WS_XN)
#define PB WSB(WS_PB)
#define XL WSF(WS_XL)
#define GG WSB(WS_GG)
#define QB_ WSB(WS_Q)
#define KB_ WSB(WS_K)
#define VB_ WSB(WS_V)
#define OB WSB(WS_O)
#define HL WSF(WS_HL)
#define PC WSF(WS_PC)
#define CHS WSF(WS_CHS)
#define AMIX WSB(WS_AMIX)
#define MIX WSF(WS_MIX)
#define X1 WSF(WS_X1)
#define HB WSB(WS_HB)
#define PROJ WSB(WS_PROJ)
#define US WSF(WS_US)
#define GUS WSF(WS_GUS)
#define GS WSF(WS_GS)
#define PJS WSF(WS_PJS)
#define QS WSF(WS_QS)
#define DP WSF(WS_DP)
    for (int u = threadIdx.x; u < (LDS_BYTES - LDSCTL_OFF) / 4; u += NWAVES * 64) ((LAS unsigned*)(F.lds + LDSCTL_OFF))[u] = 0u;
    __syncthreads();
    XcdBarrier bar; bar.bar = (unsigned*)(F.ctl + CW_BAR) + args.li * XCD_BAR_WORDS; bar.x = 0; bar.st = nullptr;
    if (args.ph_hi - args.ph_lo > 1) bar = xcd_barrier_post((unsigned*)(F.ctl + CW_BAR) + args.li * XCD_BAR_WORDS, F.MISC + 8);
    const int lo = args.ph_lo, hi = args.ph_hi;
#define IN(k) (lo <= (k) && (k) < hi)
#define BOTH(k) (IN(k) && IN((k) + 1))
#define GRID_BAR() xcd_barrier(bar)
    const int gw = F.vcu * NWAVES + F.wave, NGW = F.G * NWAVES;

    if (IN(0)) {
        const int lane = lane_now(), tid = F.wave * 64 + lane; (void)tid;
        for (int rep_ = 0; rep_ < REP_P0; ++rep_) {
        LAS float* scr = (LAS float*)(F.lds + RING_OFF + F.wave * 16384);
        constexpr int I_IN = (DM / 64) * (INW / 32), I_SQ = (DM / 64) * (DM / 32), I_G = (DM / 64) * (FF / 32), I_D = (FF / 64) * (DM / 32), I_P = (PLE / 64) * (DM / 32), I_LR = 8 * 2;
        constexpr int NITEMS = I_IN + I_SQ + 2 * I_G + I_D + I_SQ + I_P + 2 * I_LR;
        for (int it = gw; it < NITEMS; it += NGW) {
            int r = it;
            if (r < I_IN) { const int nb = INW / 32, kb = r / nb, n0 = 32 * (r % nb); p0_transpose_item(INF(I_WIN), INW, WIN, DM, 64 * kb, n0, n0, scr, lane); continue; } r -= I_IN;
            if (r < I_SQ) { const int nb = DM / 32, kb = r / nb, n0 = 32 * (r % nb); p0_transpose_item(INF(I_WOUT), DM, WOUT, DM, 64 * kb, n0, n0, scr, lane); continue; } r -= I_SQ;
            if (r < I_G) { const int nb = FF / 32, kb = r / nb, n0 = 32 * (r % nb); p0_transpose_item(INF(I_WG), FF, WGU, DM, 64 * kb, n0, 256 * (n0 >> 7) + (n0 & 127), scr, lane); continue; } r -= I_G;
            if (r < I_G) { const int nb = FF / 32, kb = r / nb, n0 = 32 * (r % nb); p0_transpose_item(INF(I_WU), FF, WGU, DM, 64 * kb, n0, 256 * (n0 >> 7) + 128 + (n0 & 127), scr, lane); continue; } r -= I_G;
            if (r < I_D) { const int nb = DM / 32, kb = r / nb, n0 = 32 * (r % nb); p0_transpose_item(INF(I_WD), DM, WD, FF, 64 * kb, n0, n0, scr, lane); continue; } r -= I_D;
            if (r < I_SQ) { const int nb = DM / 32, kb = r / nb, n0 = 32 * (r % nb); p0_transpose_item(INF(I_PWG), DM, WPG, DM, 64 * kb, n0, n0, scr, lane); continue; } r -= I_SQ;
            if (r < I_P) { const int nb = DM / 32, kb = r / nb, n0 = 32 * (r % nb); p0_transpose_item(INF(I_PWP), DM, WPP, PLE, 64 * kb, n0, n0, scr, lane); continue; } r -= I_P;
            if (r < I_LR) { const int blk = r >> 1, n0 = 32 * (r & 1); p0_transpose_item(INF(I_WA) + blk * 4096, 64, WLRU + blk * 4096, 64, 0, n0, n0, scr, lane); continue; } r -= I_LR;
            { const int blk = r >> 1, n0 = 32 * (r & 1); p0_transpose_item(INF(I_WX) + blk * 4096, 64, WLRU + 32768 + blk * 4096, 64, 0, n0, n0, scr, lane); }
        }
        for (int i = blockIdx.x * (NWAVES * 64) + tid; i < TSEQ * 8; i += F.G * NWAVES * 64) { const int pos = i >> 3, k = i & 7; const float ang = (float)pos * args.inv_freq[k];
            const double ad = (double)ang, nn = rint(ad * 0.15915494309189535); const float rf = (float)(ad - nn * 6.283185307179586);
            ROPE[(size_t)pos * 16 + k] = cosf(rf); ROPE[(size_t)pos * 16 + 8 + k] = sinf(rf); }
        { f32x4 g[4]; row_load(INF(I_NPM), lane, g);
          for (int m = gw; m < MTOT; m += NGW) { const float* xr = m < MP ? INF(I_XP) + (size_t)m * DM : INF(I_XS) + (size_t)(m - MP) * DM; f32x4 v[4]; row_load(xr, lane, v);
              const float rstd = 1.f / sqrtf(row_ssq(v) * (1.f / DM) + 1e-6f);
#pragma unroll
              for (int j = 0; j < 4; ++j) v[j] = v[j] * rstd * g[j];
              row_store_bf16(XN + (size_t)m * DM, lane, v); } }
        for (int m = gw; m < MTOT; m += NGW) { const float* pr = m < MP ? INF(I_PP) + (size_t)m * PLE : INF(I_PS) + (size_t)(m - MP) * PLE; const f32x4 v = ((const GAS f32x4*)pr)[lane];
            ((GAS unsigned long long*)(PB + (size_t)m * PLE))[lane] = (unsigned long long)pk2(v.x, v.y) | ((unsigned long long)pk2(v.z, v.w) << 32); }
        }
        if (BOTH(0)) GRID_BAR();
    }

    if (IN(1)) {
        const int lane = lane_now(), tid = F.wave * 64 + lane; (void)tid;
        { pg8::Gemm g{XN, WIN, MP, INW, DM}; pg8::StaticOrder S; S.init(MP, INW, F.G, (int)blockIdx.x);
          EpiIn E{XL, GG, QB_, KB_, VB_, args.out + OK_P, args.out + OV_P, ROPE};
          pg8::gemm_phase<EpiIn, pg8::StaticOrder, true, true>(F.lds + RING_OFF, g, S, E); }
        { const int half = F.G / 2;
          if ((int)blockIdx.x >= half) { pg8::Gemm g{PB, WPP, MP, DM, PLE}; pg8::StaticOrder S; S.init(MP, DM, F.G - half, (int)blockIdx.x - half);
              EpiBf E{PROJ, DM};
              pg8::gemm_phase<EpiBf, pg8::StaticOrder, true, true>(F.lds + RING_OFF, g, S, E); } }
        __syncthreads();
        small_gemm<0>(F, XN + (size_t)MP * DM, DM, WIN, INW, DM, US, INW);
        small_gemm<0>(F, PB + (size_t)MP * PLE, PLE, WPP, DM, PLE, PJS, DM);
        if (BOTH(1)) GRID_BAR();
    }

    if (IN(2)) {
        const int lane = lane_now(), tid = F.wave * 64 + lane; (void)tid;
        LruArgs LA{XL, INF(I_CONVW), INF(I_CONVB), WLRU, INF(I_BA), INF(I_BX), INF(I_L), HL, PC, CHS, US, INF(I_SCONV), INF(I_SH), args.out + OH_S, AMIX};
        for (int rep_ = 0; rep_ < REP_LRU; ++rep_) {
        for (int c = (int)blockIdx.x; c < NCHUNK; c += F.G) lru_unit<false>(F, LA, c);
        for (int c = F.G - 1 - (int)blockIdx.x; c < MS / 16; c += F.G) lru_unit<true>(F, LA, c);
        }
        for (int i = blockIdx.x * (NWAVES * 64) + tid; i < MS * 3 * LW; i += F.G * NWAVES * 64) { const int b = i / (3 * LW), r = (i / LW) % 3, ch = i % LW;
            args.out[OC_S + i] = r < 2 ? INF(I_SCONV)[((size_t)b * 3 + r + 1) * LW + ch] : US[(size_t)b * INW + ch]; }
        for (int i = blockIdx.x * (NWAVES * 64) + tid; i < NBATCH * 3 * LW; i += F.G * NWAVES * 64) { const int b = i / (3 * LW), r = (i / LW) % 3, ch = i % LW;
            args.out[OC_P + i] = XL[((size_t)b * TSEQ + TSEQ - 3 + r) * LW + ch]; }
        __syncthreads();
        { const attn_body::AttnTensors AT{(const attn_body::bf16*)QB_, (const attn_body::bf16*)KB_, (const attn_body::bf16*)VB_, (attn_body::bf16*)OB};
          const attn_body::StaticOrder S((int)F.G, (int)blockIdx.x);
          attn_body::attn_phase<attn_body::StaticOrder>((char*)lds + RING_OFF, AT, S); }
        __syncthreads();
        { DecArgs DA{US, ROPE, INF(I_CK), INF(I_CV), (const int*)args.in[I_PT], args.out + OK_S, args.out + OV_S, QS, DP};
          for (int u = (int)blockIdx.x; u < MS * 2; u += F.G) decode_unit(F, DA, u >> 1, u & 1);
#ifdef PROBE_DEC2
          for (int u = (int)blockIdx.x; u < MS * 2; u += F.G) decode_unit(F, DA, u >> 1, u & 1);
#endif
          }
        if (BOTH(2)) GRID_BAR();
    }

    if (IN(3)) {
        const int lane = lane_now(), tid = F.wave * 64 + lane; (void)tid;
        for (int rep_ = 0; rep_ < REP_P3; ++rep_) {
        const float lam = expf(wave_sum(INF(I_LQ1)[lane] * INF(I_LK1)[lane])) - expf(wave_sum(INF(I_LQ2)[lane] * INF(I_LK2)[lane])) + LAM_INIT;
        for (int c = (int)blockIdx.x; c < NCHUNK; c += F.G) {
            const int cb = c & ~(TSEQ / CHUNK - 1), nprev = c - cb, seg = (nprev + 7) >> 3;
            LAS float* SA = (LAS float*)(F.lds + RING_OFF); LAS float* SB = SA + 8 * LW; LAS float* CR = SB + 8 * LW;
            {
              float ca[8], cbv[8];
#pragma unroll
              for (int e = 0; e < 8; ++e) { ca[e] = 1.f; cbv[e] = 0.f; }
              const int c_lo = cb + F.wave * seg, c_hi = (c_lo + seg < c) ? c_lo + seg : c;
              for (int cc = c_lo; cc < c_hi; ++cc) { const float* pp = CHS + (size_t)cc * 2 * LW + 8 * lane; const f32x4 p0 = *(const f32x4*)pp, p1 = *(const f32x4*)(pp + 4), h0 = *(const f32x4*)(pp + LW), h1 = *(const f32x4*)(pp + LW + 4);
#pragma unroll
                  for (int e = 0; e < 4; ++e) { ca[e] *= p0[e]; cbv[e] = cbv[e] * p0[e] + h0[e]; ca[4 + e] *= p1[e]; cbv[4 + e] = cbv[4 + e] * p1[e] + h1[e]; } }
#pragma unroll
              for (int e = 0; e < 8; ++e) { SA[F.wave * LW + 8 * lane + e] = ca[e]; SB[F.wave * LW + 8 * lane + e] = cbv[e]; } }
            __syncthreads();
            { float carry = 0.f;
#pragma unroll
              for (int w2 = 0; w2 < 8; ++w2) carry = SA[w2 * LW + tid] * carry + SB[w2 * LW + tid];
              CR[tid] = carry;
              if ((c & (TSEQ / CHUNK - 1)) == TSEQ / CHUNK - 1) args.out[OH_P + (size_t)(c / (TSEQ / CHUNK)) * LW + tid] = CHS[(size_t)c * 2 * LW + tid] * carry + CHS[(size_t)c * 2 * LW + LW + tid]; }
            __syncthreads();
#pragma unroll 2
            for (int k8 = 0; k8 < 8; ++k8) { const int idx = tid + 512 * k8, r = idx >> 6, g8 = (idx & 63) * 8; const size_t o = (size_t)(c * CHUNK + r) * LW + g8;
                const f32x4 h0 = *(const f32x4*)(HL + o), h1 = *(const f32x4*)(HL + o + 4), p0 = *(const f32x4*)(PC + o), p1 = *(const f32x4*)(PC + o + 4); const v4u gw_ = *(const v4u*)(GG + o);
                const f32x4 c0 = *(const LAS f32x4*)(CR + g8), c1 = *(const LAS f32x4*)(CR + g8 + 4);
                const unsigned ga[4] = {gw_.x, gw_.y, gw_.z, gw_.w}; float y[8];
#pragma unroll
                for (int e = 0; e < 4; ++e) { y[e] = h0[e] + p0[e] * c0[e]; y[4 + e] = h1[e] + p1[e] * c1[e]; }
#pragma unroll
                for (int e = 0; e < 4; ++e) { y[2 * e] *= bf2f((unsigned short)(ga[e] & 0xffff)); y[2 * e + 1] *= bf2f((unsigned short)(ga[e] >> 16)); }
                v4u w; w.x = pk2(y[0], y[1]); w.y = pk2(y[2], y[3]); w.z = pk2(y[4], y[5]); w.w = pk2(y[6], y[7]);
                *(v4u*)(AMIX + (size_t)(c * CHUNK + r) * DM + g8) = w; }
            __syncthreads();
            for (int rr = 0; rr < 8; ++rr) { const int row = c * CHUNK + F.wave * 8 + rr;
                const v4u w1 = *(const v4u*)(OB + (size_t)row * 1024 + 8 * lane), w2 = *(const v4u*)(OB + (size_t)row * 1024 + 512 + 8 * lane);
                float o[8]; const unsigned a1[4] = {w1.x, w1.y, w1.z, w1.w}, a2[4] = {w2.x, w2.y, w2.z, w2.w};
#pragma unroll
                for (int e = 0; e < 4; ++e) { o[2 * e] = bf2f((unsigned short)(a1[e] & 0xffff)) - lam * bf2f((unsigned short)(a2[e] & 0xffff)); o[2 * e + 1] = bf2f((unsigned short)(a1[e] >> 16)) - lam * bf2f((unsigned short)(a2[e] >> 16)); }
                float ss = 0.f;
#pragma unroll
                for (int e = 0; e < 8; ++e) ss += o[e] * o[e];
                ss = row16_sum(ss);
                const float rstd = SUBLN_SCALE / sqrtf(ss * (1.f / 128.f) + 1e-5f);
                const float* gp = INF(I_SUBG) + 8 * (lane & 15); const f32x4 g0 = *(const f32x4*)gp, g1 = *(const f32x4*)(gp + 4);
                v4u w; w.x = pk2(o[0] * rstd * g0[0], o[1] * rstd * g0[1]); w.y = pk2(o[2] * rstd * g0[2], o[3] * rstd * g0[3]); w.z = pk2(o[4] * rstd * g1[0], o[5] * rstd * g1[1]); w.w = pk2(o[6] * rstd * g1[2], o[7] * rstd * g1[3]);
                *(v4u*)(AMIX + (size_t)row * DM + 512 + 8 * lane) = w; }
        }
        for (int it = gw; it < MS * 4; it += NGW) { const int b = it >> 2, head = it & 3;
            const float* q = QS + (size_t)b * AW + head * 128; const float* kn = args.out + OK_S + (size_t)b * AW + head * 128; const float* vn = args.out + OV_S + (size_t)b * AW + head * 128;
            const float s1n = wave_sum(q[lane] * kn[lane]), s2n = wave_sum(q[64 + lane] * kn[64 + lane]);
            const float* d0 = DP + ((size_t)(b * 2 + 0) * 4 + head) * DP_STRIDE; const float* d1 = DP + ((size_t)(b * 2 + 1) * 4 + head) * DP_STRIDE;
            float om[2][2];
#pragma unroll
            for (int mp = 0; mp < 2; ++mp) { const float* e0 = d0 + mp * 132; const float* e1 = d1 + mp * 132; const float sn = mp ? s2n : s1n;
                const float M = fmaxf(fmaxf(e0[128], e1[128]), sn); const float wa = __builtin_amdgcn_exp2f(e0[128] - M), wb = __builtin_amdgcn_exp2f(e1[128] - M), wn = __builtin_amdgcn_exp2f(sn - M);
                const float L = e0[129] * wa + e1[129] * wb + wn, il = 1.f / L;
                om[mp][0] = (e0[2 * lane] * wa + e1[2 * lane] * wb + vn[2 * lane] * wn) * il; om[mp][1] = (e0[2 * lane + 1] * wa + e1[2 * lane + 1] * wb + vn[2 * lane + 1] * wn) * il; }
            const float o0 = om[0][0] - lam * om[1][0], o1 = om[0][1] - lam * om[1][1];
            const float rstd = SUBLN_SCALE / sqrtf(wave_sum(o0 * o0 + o1 * o1) * (1.f / 128.f) + 1e-5f);
            *(unsigned*)(AMIX + (size_t)(MP + b) * DM + 512 + head * 128 + 2 * lane) = pk2(o0 * rstd * INF(I_SUBG)[2 * lane], o1 * rstd * INF(I_SUBG)[2 * lane + 1]); }
        }
        if (BOTH(3)) GRID_BAR();
    }

    if (IN(4)) {
        const int lane = lane_now(), tid = F.wave * 64 + lane; (void)tid;
        { pg8::Gemm g{AMIX, WOUT, MP, DM, DM}; pg8::StaticOrder S; S.init(MP, DM, F.G, (int)blockIdx.x); EpiF32 E{MIX, DM};
          pg8::gemm_phase<EpiF32, pg8::StaticOrder, true, true>(F.lds + RING_OFF, g, S, E); }
        __syncthreads();
        small_gemm<0>(F, AMIX + (size_t)MP * DM, DM, WOUT, DM, DM, MIX + (size_t)MP * DM, DM);
        if (BOTH(4)) GRID_BAR();
    }

    if (IN(5)) {
        const int lane = lane_now(), tid = F.wave * 64 + lane; (void)tid;
        for (int rep_ = 0; rep_ < REP_P5; ++rep_) {
        f32x4 g1[4], g2[4]; row_load(INF(I_NPOSTM), lane, g1); row_load(INF(I_NPREF), lane, g2);
        for (int m = gw; m < MTOT; m += NGW) { const float* xr = m < MP ? INF(I_XP) + (size_t)m * DM : INF(I_XS) + (size_t)(m - MP) * DM; f32x4 x[4], v[4]; row_load(xr, lane, x); row_load(MIX + (size_t)m * DM, lane, v);
            const float rstd = 1.f / sqrtf(row_ssq(v) * (1.f / DM) + 1e-6f);
#pragma unroll
            for (int j = 0; j < 4; ++j) x[j] = x[j] + v[j] * rstd * g1[j];
            row_store_f32(X1 + (size_t)m * DM, lane, x);
            const float rstd2 = 1.f / sqrtf(row_ssq(x) * (1.f / DM) + 1e-6f);
#pragma unroll
            for (int j = 0; j < 4; ++j) v[j] = x[j] * rstd2 * g2[j];
            row_store_bf16(XN + (size_t)m * DM, lane, v); }
        }
        if (BOTH(5)) GRID_BAR();
    }

    if (IN(6)) {
        const int lane = lane_now(), tid = F.wave * 64 + lane; (void)tid;
        { pg8::Gemm g{XN, WGU, MP, GU, DM}; pg8::StaticOrder S; S.init(MP, GU, F.G, (int)blockIdx.x); EpiSwiGlu E{HB};
          pg8::gemm_phase<EpiSwiGlu, pg8::StaticOrder, true, true>(F.lds + RING_OFF, g, S, E); }
        __syncthreads();
        small_gemm<0>(F, XN + (size_t)MP * DM, DM, WGU, GU, DM, GUS, GU);
        if (BOTH(6)) GRID_BAR();
    }

    if (IN(7)) {
        const int lane = lane_now(), tid = F.wave * 64 + lane; (void)tid;
        { pg8::Gemm g{HB, WD, MP, DM, FF}; pg8::StaticOrder S; S.init(MP, DM, F.G, (int)blockIdx.x); EpiF32 E{MIX, DM};
          pg8::gemm_phase<EpiF32, pg8::StaticOrder, true, true>(F.lds + RING_OFF, g, S, E); }
        __syncthreads();
        small_gemm<2>(F, GUS, GU, WD, DM, FF, MIX + (size_t)MP * DM, DM);
        if (BOTH(7)) GRID_BAR();
    }

    if (IN(8)) {
        const int lane = lane_now(), tid = F.wave * 64 + lane; (void)tid;
        f32x4 g1[4]; row_load(INF(I_NPOSTF), lane, g1);
        for (int m = gw; m < MTOT; m += NGW) { f32x4 x[4], v[4]; row_load(X1 + (size_t)m * DM, lane, x); row_load(MIX + (size_t)m * DM, lane, v);
            const float rstd = 1.f / sqrtf(row_ssq(v) * (1.f / DM) + 1e-6f);
#pragma unroll
            for (int j = 0; j < 4; ++j) x[j] = x[j] + v[j] * rstd * g1[j];
            row_store_f32(X1 + (size_t)m * DM, lane, x); row_store_bf16(XN + (size_t)m * DM, lane, x); }
        if (BOTH(8)) GRID_BAR();
    }

    if (IN(9)) {
        const int lane = lane_now(), tid = F.wave * 64 + lane; (void)tid;
        { pg8::Gemm g{XN, WPG, MP, DM, DM}; pg8::StaticOrder S; S.init(MP, DM, F.G, (int)blockIdx.x); EpiPle E{PROJ, MIX};
          pg8::gemm_phase<EpiPle, pg8::StaticOrder, true, true>(F.lds + RING_OFF, g, S, E); }
        __syncthreads();
        small_gemm<0>(F, XN + (size_t)MP * DM, DM, WPG, DM, DM, GS, DM);
        if (BOTH(9)) GRID_BAR();
    }

    if (IN(10)) {
        const int lane = lane_now(), tid = F.wave * 64 + lane; (void)tid;
        for (int rep_ = 0; rep_ < REP_P10; ++rep_) {
        f32x4 g1[4]; row_load(INF(I_PNORM), lane, g1);
        for (int m = gw; m < MTOT; m += NGW) { f32x4 x[4], v[4]; row_load(X1 + (size_t)m * DM, lane, x);
            if (m < MP) row_load(MIX + (size_t)m * DM, lane, v);
            else { f32x4 a[4], b[4]; row_load(GS + (size_t)(m - MP) * DM, lane, a); row_load(PJS + (size_t)(m - MP) * DM, lane, b);
#pragma unroll
                for (int j = 0; j < 4; ++j) { v[j].x = sigmoidf_(a[j].x) * b[j].x; v[j].y = sigmoidf_(a[j].y) * b[j].y; v[j].z = sigmoidf_(a[j].z) * b[j].z; v[j].w = sigmoidf_(a[j].w) * b[j].w; } }
            const float rstd = 1.f / sqrtf(row_ssq(v) * (1.f / DM) + 1e-6f);
#pragma unroll
            for (int j = 0; j < 4; ++j) x[j] = x[j] + v[j] * rstd * g1[j];
            row_store_f32(m < MP ? args.out + OY_P + (size_t)m * DM : args.out + OY_S + (size_t)(m - MP) * DM, lane, x); }
        }
    }
#undef IN
#undef BOTH
#undef INF
}

extern "C" void kernel_launch(void* const* d_in, const int* in_sizes, int n_in, void* d_out, int out_size, void* d_ws, size_t ws_size, hipStream_t stream) {
    static int grid = 0;
    if (grid == 0) {
        if (n_in != 33 || (size_t)out_size != OUT_TOTAL || ws_size < WS_END) { fprintf(stderr, "kernel_launch: unexpected sizes (n_in %d, out %d, ws %zu, need %zu)\n", n_in, out_size, ws_size, (size_t)WS_END); grid = -1; return; }
        int dev = 0, cus = 0, per_cu = 0;
        if (hipGetDevice(&dev) != hipSuccess || hipDeviceGetAttribute(&cus, hipDeviceAttributeMultiprocessorCount, dev) != hipSuccess) { grid = -1; return; }
        if (hipFuncSetAttribute((const void*)hymba_fwd, hipFuncAttributeMaxDynamicSharedMemorySize, LDS_BYTES) != hipSuccess) { fprintf(stderr, "kernel_launch: hipFuncSetAttribute failed\n"); grid = -1; return; }
        if (hipOccupancyMaxActiveBlocksPerMultiprocessor(&per_cu, (const void*)hymba_fwd, NWAVES * 64, LDS_BYTES) != hipSuccess || per_cu < 1) { fprintf(stderr, "kernel_launch: occupancy query says %d\n", per_cu); }
        (void)hipGetLastError();
        grid = cus;
    }
    if (grid < 0) return;
    (void)hipMemsetAsync((char*)d_ws + WS_CTL, 0, CTL_ZERO_BYTES, stream);
    Args a{};
    for (int i = 0; i < 33; ++i) a.in[i] = d_in[i];
    a.out = (float*)d_out; a.ws = (unsigned char*)d_ws;
    for (int i = 0; i < 8; ++i) a.inv_freq[i] = (float)pow(500000.0, -(double)i / 8.0);
    constexpr int NL = MK_N_LAUNCHES;
    for (int li = 0; li < NL; ++li) {
        a.ph_lo = (NL == 1) ? 0 : li; a.ph_hi = (NL == 1) ? N_PHASES : li + 1; a.li = (NL == 1) ? 0 : 0; a.pad = 0;
        hipLaunchKernelGGL(hymba_fwd, dim3(grid), dim3(NWAVES * 64), LDS_BYTES, stream, a);
    }
}
```

```cpp
#include <hip/hip_runtime.h>
__device__ __forceinline__ int lane_now() { int l; asm volatile("v_mbcnt_lo_u32_b32 %0, -1, 0\n\tv_mbcnt_hi_u32_b32 %0, -1, %0" : "=v"(l)); return l; }
#include <hip/hip_runtime.h>
#include <cstdio>
#include <cstdint>
namespace pg8 {
#define PG8_LAS __attribute__((address_space(3)))
typedef unsigned short bf16_t;
typedef short bf16x8 __attribute__((ext_vector_type(8)));
typedef float f32x4 __attribute__((ext_vector_type(4)));
typedef unsigned u32x4 __attribute__((ext_vector_type(4)));
constexpr int BM = 256, BK = 64, HALF = 128, HTB = HALF * BK * 2  , STAGE_BYTES = 8 * HTB, NXCD = 8, WGM = 8;

__host__ __device__ __forceinline__ int lds_byte(int r, int c) { const int st = (r >> 4) * 2 + (c >> 5), rr = r & 15, cc = c & 31, ob = rr * 64 + cc * 2; return st * 1024 + (ob ^ (((ob >> 9) & 1) << 5)); }
__host__ __device__ __forceinline__ void stage_rc(int b, int& R, int& C) { const int st = b / 1024, sb = b % 1024, swz = sb ^ (((sb >> 9) & 1) << 5); R = (st >> 1) * 16 + swz / 64; C = (st & 1) * 32 + (swz % 64) / 2; }
__host__ __device__ __forceinline__ int perm32(int rho) { const int n = rho >> 4, i = rho & 15; return 8 * (i >> 2) + 4 * n + (i & 3); }

struct Unit { int pm, pn; };
struct Gemm { const bf16_t* A; const bf16_t* Bt; int M, N, K; };

struct StaticOrder {
    int nM, nN, nwg, G, c;
    __host__ __device__ void init(int M, int N, int G_, int c_) { nM = M / BM; nN = N / BM; nwg = nM * nN; G = G_; c = c_; }
    __host__ __device__ bool next(int i, Unit& u) const {
        const long L = (long)i * G + c; if (L >= nwg) return false;
        int wgid = (int)L; { const int q = nwg / NXCD, r = nwg % NXCD, xcd = wgid % NXCD, off = wgid / NXCD; wgid = (xcd < r ? xcd * (q + 1) : r * (q + 1) + (xcd - r) * q) + off; }
        const int nig = WGM * nN, gid = wgid / nig, fm = gid * WGM, gsz = (nM - fm) < WGM ? (nM - fm) : WGM;
        u.pm = fm + ((wgid % nig) % gsz); u.pn = (wgid % nig) / gsz; return true;
    }
    __device__ __forceinline__ void a_ready(const Unit&) const {}
    __device__ __forceinline__ void done(const Unit&) const {}
};

typedef float f32x2 __attribute__((ext_vector_type(2)));
template <class Epi, class Sched, bool ALIGN_EPI = false, bool SP2 = false>
__device__ __forceinline__ void gemm_phase(PG8_LAS unsigned char* lds, const Gemm g, const Sched& S, const Epi& E) {
    const int tid = threadIdx.x, wid = __builtin_amdgcn_readfirstlane(tid >> 6), lane = tid & 63, wr = wid >> 2, wc = wid & 3, fr = lane & 15, fq = lane >> 4;
    const int K = g.K, nt = K / BK;
    unsigned voffA[2], voffB[2];
#pragma unroll
    for (int i = 0; i < 2; ++i) { int R, C; stage_rc(tid * 16 + i * 8192, R, C); const int Rb = Epi::PERM ? ((R & ~31) + perm32(R & 31)) : R;
        voffA[i] = (unsigned)(R * K + C) * 2u; voffB[i] = (unsigned)(Rb * K + C) * 2u; }
    const size_t kstep = (size_t)(BK * 2);
    const size_t hstep = (size_t)HALF * K * 2;
    const size_t tstep = 2 * hstep;
    const unsigned ldsw = (unsigned)wid * 1024u;
    const int aoff = lds_byte(wr * 64 + fr, fq * 8), boff = lds_byte(wc * 32 + fr, fq * 8);
#define PG8_SA(b, h) (((b) * 2 + (h)) * HTB)
#define PG8_SB(b, h) ((4 + (b) * 2 + (h)) * HTB)
#define PG8_STAGE(bufoff, gbase, voff) do { _Pragma("unroll") for (int _i = 0; _i < 2; ++_i) \
        __builtin_amdgcn_global_load_lds((const unsigned*)((const char*)(gbase) + (voff)[_i]), (PG8_LAS unsigned*)(lds + (bufoff) + ldsw + _i * 8192), 16, 0, 0); } while (0)
#define PG8_LDA(dst, b, h) do { _Pragma("unroll") for (int m = 0; m < 4; ++m) _Pragma("unroll") for (int k = 0; k < 2; ++k) dst[m][k] = *(const PG8_LAS bf16x8*)(lds + PG8_SA(b, h) + aoff + m * 2048 + k * 1024); } while (0)
#define PG8_LDB(dst, b, h) do { _Pragma("unroll") for (int n = 0; n < 2; ++n) _Pragma("unroll") for (int k = 0; k < 2; ++k) dst[n][k] = *(const PG8_LAS bf16x8*)(lds + PG8_SB(b, h) + boff + n * 2048 + k * 1024); } while (0)
#define PG8_MMA(ai, bj, At, Bt) do { __builtin_amdgcn_s_setprio(1); _Pragma("unroll") for (int m = 0; m < 4; ++m) _Pragma("unroll") for (int n = 0; n < 2; ++n) _Pragma("unroll") for (int k = 0; k < 2; ++k) \
        acc[ai][bj][m][n] = __builtin_amdgcn_mfma_f32_16x16x32_bf16(Bt[n][k], At[m][k], acc[ai][bj][m][n], 0, 0, 0); __builtin_amdgcn_s_setprio(0); } while (0)
#define PG8_WAIT_V(n) asm volatile("s_waitcnt vmcnt(" #n ")" ::: "memory")
#define PG8_WAIT_L(n) asm volatile("s_waitcnt lgkmcnt(" #n ")" ::: "memory")
#define PG8_BAR __builtin_amdgcn_s_barrier()
#define PG8_SCHED __builtin_amdgcn_sched_barrier(0)
    Unit cur, nxt; int ui = 0;
    if (!S.next(0, cur)) return;
    f32x4 acc[2][2][4][2];
#pragma unroll
    for (int a = 0; a < 2; ++a)
#pragma unroll
        for (int b = 0; b < 2; ++b)
#pragma unroll
            for (int m = 0; m < 4; ++m)
#pragma unroll
                for (int n = 0; n < 2; ++n) acc[a][b][m][n] = (f32x4){0.f, 0.f, 0.f, 0.f};
    bf16x8 At[4][2], B0[2][2], B1[2][2];
    const char* cA = (const char*)g.A + (size_t)cur.pm * tstep; const char* cB = (const char*)g.Bt + (size_t)cur.pn * tstep;
    S.a_ready(cur);
    if constexpr (SP2) {
        PG8_STAGE(PG8_SB(0, 0), cB, voffB); PG8_STAGE(PG8_SB(0, 1), cB + hstep, voffB); PG8_STAGE(PG8_SA(0, 0), cA, voffA); PG8_STAGE(PG8_SA(0, 1), cA + hstep, voffA);
        if (wr == 1) PG8_BAR;
        PG8_WAIT_V(2); PG8_BAR;
        PG8_STAGE(PG8_SB(1, 0), cB + kstep, voffB); PG8_STAGE(PG8_SA(1, 0), cA + kstep, voffA); PG8_STAGE(PG8_SB(1, 1), cB + hstep + kstep, voffB);
        PG8_WAIT_V(6); PG8_BAR;
    } else {
        PG8_STAGE(PG8_SB(0, 0), cB, voffB); PG8_STAGE(PG8_SA(0, 0), cA, voffA); PG8_STAGE(PG8_SB(0, 1), cB + hstep, voffB); PG8_STAGE(PG8_SA(0, 1), cA + hstep, voffA);
        if (wr == 1) PG8_BAR;
        PG8_WAIT_V(4); PG8_BAR;
        PG8_STAGE(PG8_SB(1, 0), cB + kstep, voffB); PG8_STAGE(PG8_SA(1, 0), cA + kstep, voffA); PG8_STAGE(PG8_SB(1, 1), cB + hstep + kstep, voffB);
        PG8_WAIT_V(6); PG8_BAR;
    }
    for (;;) {
        const bool has_next = S.next(ui + 1, nxt);
        const char* nA = has_next ? (const char*)g.A + (size_t)nxt.pm * tstep : cA; const char* nB = has_next ? (const char*)g.Bt + (size_t)nxt.pn * tstep : cB;
        for (int t = 0; t < nt; t += 2) {
            const bool last = (t == nt - 2);
            const char* a1 = cA + (size_t)(t + 1) * kstep;
            const char* a2 = last ? nA : cA + (size_t)(t + 2) * kstep; const char* b2 = last ? nB : cB + (size_t)(t + 2) * kstep;
            const char* a3 = a2 + kstep; const char* b3 = b2 + kstep;
            if (last && has_next) S.a_ready(nxt);
            if constexpr (SP2) {
            PG8_LDB(B0, 0, 0); PG8_LDB(B1, 0, 1); PG8_SCHED; PG8_LDA(At, 0, 0); PG8_STAGE(PG8_SA(1, 1), a1 + hstep, voffA);
            PG8_WAIT_V(8); PG8_WAIT_L(0); PG8_BAR; PG8_MMA(0, 0, At, B0); PG8_MMA(0, 1, At, B1); PG8_BAR; PG8_SCHED;
            PG8_LDA(At, 0, 1); PG8_STAGE(PG8_SB(0, 0), b2, voffB); PG8_STAGE(PG8_SB(0, 1), b2 + hstep, voffB); PG8_STAGE(PG8_SA(0, 0), a2, voffA);
            PG8_WAIT_V(8); PG8_WAIT_L(0); PG8_BAR; PG8_MMA(1, 0, At, B0); PG8_MMA(1, 1, At, B1); PG8_BAR; PG8_SCHED;
            PG8_LDB(B0, 1, 0); PG8_LDB(B1, 1, 1); PG8_SCHED; PG8_LDA(At, 1, 0); PG8_STAGE(PG8_SA(0, 1), a2 + hstep, voffA);
            PG8_WAIT_V(8); PG8_WAIT_L(0); PG8_BAR; PG8_MMA(0, 0, At, B0); PG8_MMA(0, 1, At, B1); PG8_BAR; PG8_SCHED;
            PG8_LDA(At, 1, 1); PG8_STAGE(PG8_SB(1, 0), b3, voffB); PG8_STAGE(PG8_SB(1, 1), b3 + hstep, voffB); PG8_STAGE(PG8_SA(1, 0), a3, voffA);
            PG8_WAIT_V(8); PG8_WAIT_L(0); PG8_BAR; PG8_MMA(1, 0, At, B0); PG8_MMA(1, 1, At, B1); PG8_BAR; PG8_SCHED;
            } else {
            PG8_LDB(B0, 0, 0); PG8_SCHED; PG8_LDA(At, 0, 0); PG8_STAGE(PG8_SA(1, 1), a1 + hstep, voffA);
            PG8_WAIT_L(8); PG8_BAR; PG8_WAIT_L(0); PG8_MMA(0, 0, At, B0); PG8_BAR; PG8_SCHED;
            PG8_LDB(B1, 0, 1); PG8_STAGE(PG8_SB(0, 0), b2, voffB);
            PG8_BAR; PG8_WAIT_L(0); PG8_MMA(0, 1, At, B1); PG8_BAR;
            PG8_LDA(At, 0, 1); PG8_STAGE(PG8_SA(0, 0), a2, voffA);
            PG8_BAR; PG8_WAIT_L(0); PG8_MMA(1, 0, At, B0); PG8_BAR; PG8_SCHED;
            PG8_STAGE(PG8_SB(0, 1), b2 + hstep, voffB);
            PG8_WAIT_V(6); PG8_BAR; PG8_MMA(1, 1, At, B1); PG8_BAR;
            PG8_LDB(B0, 1, 0); PG8_SCHED; PG8_LDA(At, 1, 0); PG8_STAGE(PG8_SA(0, 1), a2 + hstep, voffA);
            PG8_WAIT_L(8); PG8_BAR; PG8_WAIT_L(0); PG8_MMA(0, 0, At, B0); PG8_BAR; PG8_SCHED;
            PG8_LDB(B1, 1, 1); PG8_STAGE(PG8_SB(1, 0), b3, voffB);
            PG8_BAR; PG8_WAIT_L(0); PG8_MMA(0, 1, At, B1); PG8_BAR;
            PG8_LDA(At, 1, 1); PG8_STAGE(PG8_SA(1, 0), a3, voffA);
            PG8_BAR; PG8_WAIT_L(0); PG8_MMA(1, 0, At, B0); PG8_BAR; PG8_SCHED;
            PG8_STAGE(PG8_SB(1, 1), b3 + hstep, voffB);
            PG8_WAIT_V(6); PG8_BAR; PG8_MMA(1, 1, At, B1); PG8_BAR;
            }
        }
        if constexpr (ALIGN_EPI) { if (wr == 0) PG8_BAR; }
        if constexpr (!Epi::AFTER_DRAIN) { E(acc, cur, wr, wc, fr, fq); S.done(cur); }
        if (!has_next) break;
#pragma unroll
        for (int a = 0; a < 2; ++a)
#pragma unroll
            for (int b = 0; b < 2; ++b)
#pragma unroll
                for (int m = 0; m < 4; ++m)
#pragma unroll
                    for (int n = 0; n < 2; ++n) acc[a][b][m][n] = (f32x4){0.f, 0.f, 0.f, 0.f};
        cur = nxt; cA = nA; cB = nB; ++ui;
        if constexpr (ALIGN_EPI) { if (wr == 1) PG8_BAR; }
    }
    PG8_WAIT_V(0);
    if constexpr (!ALIGN_EPI) { if (wr == 0) PG8_BAR; }
    PG8_BAR;
    if constexpr (Epi::AFTER_DRAIN) { E.fused(acc, cur, wr, wc, fr, fq, lds, wid, lane); S.done(cur); }
#undef PG8_SA
#undef PG8_SB
#undef PG8_STAGE
#undef PG8_LDA
#undef PG8_LDB
#undef PG8_MMA
#undef PG8_WAIT_V
#undef PG8_WAIT_L
#undef PG8_BAR
#undef PG8_SCHED
}
}

#include <hip/hip_bf16.h>
#include <cmath>
namespace attn_body {
using bf16=__hip_bfloat16;
using bf16x8=__attribute__((ext_vector_type(8)))short;
using s16x4=__attribute__((ext_vector_type(4)))short;
using f32x16=__attribute__((ext_vector_type(16)))float;
using u32x4=__attribute__((ext_vector_type(4)))unsigned;
constexpr int BATCH=2,NHEAD=16,SEQ=8192,D=64,PQ=512,PO=1024;
constexpr int NW=8,QBLK=32,QB=QBLK*NW,KVBLK=64,NQB=SEQ/QB;
constexpr int ATTN_UNIT_ROWS=QB;
__device__ __forceinline__ int crow(int r,int hi){return (r&3)+8*(r>>2)+4*hi;}
#define SBAR() __builtin_amdgcn_sched_barrier(0)
__device__ __forceinline__ void cmask(f32x16&p0,f32x16&p1,int jb,int qrel,int hi){
  const float NEG=-INFINITY; int kb=64*jb+4*hi;
  #pragma unroll
  for(int r=0;r<16;++r){int kv=kb+(r&3)+8*(r>>2); if(kv>qrel)p0[r]=NEG; if(kv+32>qrel)p1[r]=NEG;}
}

constexpr int NSLOT=3, SLOTB=8192;
constexpr int LDS_K=0, LDS_V=NSLOT*SLOTB, LDS_WS=2*NSLOT*SLOTB, LDS_OST=LDS_WS+NW*64*4, LDS_BYTES=LDS_OST+NW*4096;
constexpr float C2=0.125f*1.4426950408889634f;
__device__ __forceinline__ void glds16(const void*gsrc,unsigned lds_dst){unsigned keep;
  asm volatile("s_mov_b32 %0, m0\n\ts_mov_b32 m0, %2\n\ts_nop 0\n\tglobal_load_lds_dwordx4 %1, off\n\ts_mov_b32 m0, %0":"=&s"(keep):"v"(gsrc),"s"(lds_dst):"memory");}
__device__ __forceinline__ float max3f(float a,float b,float c){float r;asm("v_max3_f32 %0, %1, %2, %3":"=v"(r):"v"(a),"v"(b),"v"(c));return r;}
__device__ __forceinline__ float max2f(float a,float b){float r;asm("v_max_f32_e32 %0, %1, %2":"=v"(r):"v"(a),"v"(b));return r;}
__device__ __forceinline__ float fadd_s(float a,float b){float r;asm("v_add_f32_e32 %0, %1, %2":"=v"(r):"v"(a),"v"(b));return r;}
__device__ __forceinline__ float fsub_s(float a,float b){float r;asm("v_sub_f32_e32 %0, %1, %2":"=v"(r):"v"(a),"v"(b));return r;}
typedef float f32x2_t __attribute__((ext_vector_type(2))); typedef __bf16 bf16x2_t __attribute__((ext_vector_type(2)));
__device__ __forceinline__ unsigned cvtpk_s(float lo,float hi){f32x2_t v={lo,hi};bf16x2_t b=__builtin_convertvector(v,bf16x2_t);return __builtin_bit_cast(unsigned,b);}
#define WAIT_BAR(N) asm volatile("s_waitcnt vmcnt(" #N ") lgkmcnt(0)\n\ts_barrier":::"memory")

__device__ __forceinline__ void qkt(f32x16&p0,f32x16&p1,const char*Kslot,const bf16x8*qr,const f32x16&negm,int r32,int hi){
  const char*kb=Kslot+hi*1024+r32*16;
  #pragma unroll
  for(int d0=0;d0<4;++d0){
    const bf16x8 b0=*reinterpret_cast<const bf16x8*>(kb+d0*2048);
    const bf16x8 b1=*reinterpret_cast<const bf16x8*>(kb+d0*2048+512);
    if(d0==0){p0=__builtin_amdgcn_mfma_f32_32x32x16_bf16(b0,qr[0],negm,0,0,0);p1=__builtin_amdgcn_mfma_f32_32x32x16_bf16(b1,qr[0],negm,0,0,0);}
    else{p0=__builtin_amdgcn_mfma_f32_32x32x16_bf16(b0,qr[d0],p0,0,0,0);p1=__builtin_amdgcn_mfma_f32_32x32x16_bf16(b1,qr[d0],p1,0,0,0);}}
}
typedef __attribute__((address_space(3))) const char* lds_cptr;
typedef short v4i16_t __attribute__((ext_vector_type(4)));
__device__ __forceinline__ void kload8(bf16x8*kf,lds_cptr kp){
  kf[0]=*(const __attribute__((address_space(3))) bf16x8*)(kp);      kf[1]=*(const __attribute__((address_space(3))) bf16x8*)(kp+512);
  kf[2]=*(const __attribute__((address_space(3))) bf16x8*)(kp+2048); kf[3]=*(const __attribute__((address_space(3))) bf16x8*)(kp+2560);
  kf[4]=*(const __attribute__((address_space(3))) bf16x8*)(kp+4096); kf[5]=*(const __attribute__((address_space(3))) bf16x8*)(kp+4608);
  kf[6]=*(const __attribute__((address_space(3))) bf16x8*)(kp+6144); kf[7]=*(const __attribute__((address_space(3))) bf16x8*)(kp+6656);
}
__device__ __forceinline__ void kload2(bf16x8*kf,lds_cptr kp,int j){ kf[2*j]=*(const __attribute__((address_space(3))) bf16x8*)(kp+j*2048); kf[2*j+1]=*(const __attribute__((address_space(3))) bf16x8*)(kp+j*2048+512); }
__device__ __forceinline__ s16x4 vtr(lds_cptr p){ return __builtin_bit_cast(s16x4,__builtin_amdgcn_ds_read_tr16_b64_v4i16((__attribute__((address_space(3))) v4i16_t*)p)); }
__device__ __forceinline__ float rowmax(const f32x16&p0,const f32x16&p1){
  float a=max3f(p0[0],p0[1],p1[0]),b=max3f(p0[2],p0[3],p1[1]);a=max3f(a,p1[2],p1[3]);
  #pragma unroll
  for(int r=4;r<16;r+=4){a=max3f(a,p0[r],p0[r+1]);b=max3f(b,p0[r+2],p0[r+3]);a=max3f(a,p1[r],p1[r+1]);b=max3f(b,p1[r+2],p1[r+3]);}
  const float m=max2f(a,b);
  auto rr=__builtin_amdgcn_permlane32_swap(__float_as_uint(m),__float_as_uint(m),false,false);
  return max2f(__uint_as_float(rr[0]),__uint_as_float(rr[1]));
}
__device__ __forceinline__ void pv(f32x16*o,int vb,bf16x8 pa0,bf16x8 pa1,bf16x8 pa2,bf16x8 pa3){
  #pragma unroll
  for(int d0=0;d0<2;++d0){s16x4 lo[4],hi[4];
    #pragma unroll
    for(int ks=0;ks<4;++ks){
      asm volatile("ds_read_b64_tr_b16 %0,%1 offset:%c2":"=&v"(lo[ks]):"v"(vb),"i"(d0*4096+ks*1024):"memory");
      asm volatile("ds_read_b64_tr_b16 %0,%1 offset:%c2":"=&v"(hi[ks]):"v"(vb),"i"(d0*4096+ks*1024+512):"memory");}
    asm volatile("s_waitcnt lgkmcnt(0)":::"memory");SBAR();
    #define PK(k) (bf16x8){lo[k][0],lo[k][1],lo[k][2],lo[k][3],hi[k][0],hi[k][1],hi[k][2],hi[k][3]}
    o[d0]=__builtin_amdgcn_mfma_f32_32x32x16_bf16(pa0,PK(0),o[d0],0,0,0);
    o[d0]=__builtin_amdgcn_mfma_f32_32x32x16_bf16(pa1,PK(1),o[d0],0,0,0);
    o[d0]=__builtin_amdgcn_mfma_f32_32x32x16_bf16(pa2,PK(2),o[d0],0,0,0);
    o[d0]=__builtin_amdgcn_mfma_f32_32x32x16_bf16(pa3,PK(3),o[d0],0,0,0);
    #undef PK
  }
}

#ifndef ATTN_STORE16
#define ATTN_STORE16(p,v) (*(u32x4*)(p)=(v))
#endif
template<int THRL> __device__ __forceinline__ void attn_unit(int b,int qoff,int koff,int voff,int ooff,int qb,const bf16*Q,const bf16*__restrict__ K,const bf16*__restrict__ V,bf16*O,char*shm){
  const int lane=lane_now(),r32=lane&31,hi=lane>>5; const int wid=__builtin_amdgcn_readfirstlane((int)threadIdx.x>>6);
  const long rowbase=(long)b*SEQ; const int q0=qb*QB;
  const bf16*Qw=Q+(rowbase+q0+wid*QBLK)*PQ+qoff;
  const bf16*Kh=K+rowbase*PQ+koff,*Vh=V+rowbase*PQ+voff;
  const unsigned lds0=(unsigned)(uintptr_t)shm;
  float*wsf=(float*)(shm+LDS_WS)+wid*64;
  const bf16*ksrc=Kh+(long)lane*PQ+wid*8;
  const bf16*vsrc=Vh+(long)(16*(wid&3)+(lane>>2))*PQ+(wid>>2)*32+(lane&3)*8;
  const unsigned kdst=lds0+LDS_K+wid*1024, vdst=lds0+LDS_V+wid*1024;
  #define DMA_K(t,slot) glds16(ksrc+(long)(t)*KVBLK*PQ,(unsigned)__builtin_amdgcn_readfirstlane(kdst+(slot)))
  #define DMA_V(t,slot) glds16(vsrc+(long)(t)*KVBLK*PQ,(unsigned)__builtin_amdgcn_readfirstlane(vdst+(slot)))
  const int vb0=(int)(lds0+LDS_V)+((lane>>4)&1)*32+(lane&3)*8+(4*hi+((lane&15)>>2))*64;
  const char*Kbase=shm+LDS_K; bf16x8 kf[8];
  const lds_cptr shm3=(lds_cptr)shm; const lds_cptr kp0=shm3+LDS_K+hi*1024+r32*16; const lds_cptr vp0=shm3+LDS_V+((lane>>4)&1)*32+(lane&3)*8+(4*hi+((lane&15)>>2))*64;
  const int NT=(q0+QB)/KVBLK;
  DMA_K(0,0);DMA_V(0,0);DMA_K(1,SLOTB);
  bf16x8 qr[4];
  #pragma unroll
  for(int d0=0;d0<4;++d0)qr[d0]=*reinterpret_cast<const bf16x8*>(&Qw[(long)r32*PQ+d0*16+hi*8]);
  float mhat=0.f,l_reg=0.f;f32x16 o[2];o[0]=f32x16{};o[1]=f32x16{};f32x16 negm=f32x16{};asm volatile("":"+v"(negm));
  const int qrel=wid*QBLK+r32;
  #define CMASK(P0,P1,t) do{int jb_=(t)-(NT-4); if(jb_>=0)cmask(P0,P1,jb_,qrel,hi);}while(0)
  bool resc=false;
  #define START(P0,P1) do{ const float rm=rowmax(P0,P1); resc=false; \
    { const float dl=rm; mhat=fadd_s(mhat,dl); \
      _Pragma("unroll") for(int r=0;r<16;++r){P0[r]=fsub_s(P0[r],dl);P1[r]=fsub_s(P1[r],dl);} \
      _Pragma("unroll") for(int r=0;r<16;++r)negm[r]=-mhat; asm volatile("":"+v"(negm)); } \
    _Pragma("unroll") for(int r=0;r<16;++r)P0[r]=__builtin_amdgcn_exp2f(P0[r]); }while(0)
  #define RESC() do{ if(resc){ asm volatile("s_waitcnt lgkmcnt(0)":::"memory"); \
      _Pragma("unroll") for(int d_=0;d_<2;++d_) _Pragma("unroll") for(int r=0;r<16;++r)o[d_][r]*=wsf[crow(r,hi)]; } }while(0)
  f32x16 pA0,pA1,pB0,pB1;
  int sl_prev=0,sl_cur=0,sl_next=SLOTB;
  #define ROT() do{sl_prev=sl_cur;sl_cur=sl_next;sl_next=(sl_next==(NSLOT-1)*SLOTB)?0:sl_next+SLOTB;}while(0)
  DMA_K(2,2*SLOTB);
  WAIT_BAR(3);
  qkt(pA0,pA1,Kbase,qr,negm,r32,hi);asm volatile("s_nop 15\n\ts_nop 7":"+v"(pA0),"+v"(pA1));CMASK(pA0,pA1,0);
  START(pA0,pA1);
  _Pragma("unroll") for(int r=0;r<16;++r)pA1[r]=__builtin_amdgcn_exp2f(pA1[r]);
  WAIT_BAR(0);
  DMA_K(3,0);DMA_V(1,SLOTB);
  ROT();
  kload8(kf,kp0+sl_cur);
  WAIT_BAR(2);
  s16x4 vlo[8],vhi[8]; u32x4 pw0,pw1,pw2,pw3;
  #define PKW(P,B) cvtpk_s(P[B],P[B+1])
  #define PAF(k) __builtin_bit_cast(bf16x8,pw##k)
  #define VFR(i) (bf16x8){vlo[i][0],vlo[i][1],vlo[i][2],vlo[i][3],vhi[i][0],vhi[i][1],vhi[i][2],vhi[i][3]}
  #define PIN(x) asm volatile("":"+v"(x))
  #define MX3(a,b,c) __builtin_fmaxf(__builtin_fmaxf((a),(b)),(c))
  #define GAPA(MF,A0,A1,A2,A3,W0,W1,PW) do{ MF; sacc+=A0; sacc+=A1; sacc+=A2; sacc+=A3; PIN(sacc); W0; W1; PIN(PW); SBAR(); }while(0)
  #define EX(v) __builtin_amdgcn_exp2f(v)
  #define GAPB(MF,X,B) do{ MF; X[B]=EX(X[B]); X[B+1]=EX(X[B+1]); X[B+2]=EX(X[B+2]); X[B+3]=EX(X[B+3]); PIN(X); SBAR(); }while(0)
  #define VRD(i) do{ vlo[i]=vtr(vp_+(((i)>>2)*4096+((i)&3)*1024)); vhi[i]=vtr(vp_+(((i)>>2)*4096+((i)&3)*1024+512)); }while(0)
  #define KRD(G,j) do{ if(G){ kload2(kf,kp0+sl_next,j); SBAR(); } }while(0)
  #define STEP(C0,C1,P0,P1,t,GK,GV,GL) do{ SBAR(); \
    const lds_cptr vp_=vp0+sl_prev; \
    VRD(0); SBAR(); float sacc=(P0[0]+P0[1]); \
    GAPA(C0=__builtin_amdgcn_mfma_f32_32x32x16_bf16(kf[0],qr[0],negm,0,0,0), P0[2],P0[3],P0[4],P0[5],     pw0[0]=PKW(P0,0), pw0[1]=PKW(P0,2), pw0); \
    VRD(4); SBAR(); GAPA(C1=__builtin_amdgcn_mfma_f32_32x32x16_bf16(kf[1],qr[0],negm,0,0,0), P0[6],P0[7],P0[8],P0[9],     pw0[2]=PKW(P0,4), pw0[3]=PKW(P0,6), pw0); \
    VRD(1); SBAR(); GAPA(C0=__builtin_amdgcn_mfma_f32_32x32x16_bf16(kf[2],qr[1],C0,0,0,0),   P0[10],P0[11],P0[12],P0[13], pw1[0]=PKW(P0,8), pw1[1]=PKW(P0,10), pw1); \
    VRD(5); SBAR(); GAPA(C1=__builtin_amdgcn_mfma_f32_32x32x16_bf16(kf[3],qr[1],C1,0,0,0),   P0[14],P0[15],P1[0],P1[1],   pw1[2]=PKW(P0,12),pw1[3]=PKW(P0,14), pw1); \
    VRD(2); SBAR(); GAPA(C0=__builtin_amdgcn_mfma_f32_32x32x16_bf16(kf[4],qr[2],C0,0,0,0),   P1[2],P1[3],P1[4],P1[5],     pw2[0]=PKW(P1,0), pw2[1]=PKW(P1,2), pw2); \
    VRD(6); SBAR(); GAPA(C1=__builtin_amdgcn_mfma_f32_32x32x16_bf16(kf[5],qr[2],C1,0,0,0),   P1[6],P1[7],P1[8],P1[9],     pw2[2]=PKW(P1,4), pw2[3]=PKW(P1,6), pw2); \
    VRD(3); SBAR(); GAPA(C0=__builtin_amdgcn_mfma_f32_32x32x16_bf16(kf[6],qr[3],C0,0,0,0),   P1[10],P1[11],P1[12],P1[13], pw3[0]=PKW(P1,8), pw3[1]=PKW(P1,10), pw3); \
    VRD(7); SBAR(); GAPA(C1=__builtin_amdgcn_mfma_f32_32x32x16_bf16(kf[7],qr[3],C1,0,0,0),   P1[14],P1[15],0.f,0.f,       pw3[2]=PKW(P1,12),pw3[3]=PKW(P1,14), pw3); \
    l_reg+=sacc; \
    if(GK){DMA_K((t)+3,sl_cur);} if(GV){DMA_V((t)+1,sl_next);} \
    CMASK(C0,C1,t); \
    { float a=MX3(C0[0],C0[1],C1[0]),b=MX3(C0[2],C0[3],C1[1]); a=MX3(a,C1[2],C1[3]); \
      _Pragma("unroll") for(int r=4;r<16;r+=4){a=MX3(a,C0[r],C0[r+1]);b=MX3(b,C0[r+2],C0[r+3]);a=MX3(a,C1[r],C1[r+1]);b=MX3(b,C1[r+2],C1[r+3]);} \
      float rm=__builtin_fmaxf(a,b); { auto rr=__builtin_amdgcn_permlane32_swap(__float_as_uint(rm),__float_as_uint(rm),false,false); rm=__builtin_fmaxf(__uint_as_float(rr[0]),__uint_as_float(rr[1])); } \
      resc=false; \
      if(__builtin_expect(__any(rm>(float)THRL),0)){ const float dl=__builtin_fmaxf(rm,0.f); mhat+=dl; \
        _Pragma("unroll") for(int r=0;r<16;++r){C0[r]-=dl;C1[r]-=dl;} \
        _Pragma("unroll") for(int r=0;r<16;++r)negm[r]=-mhat; asm volatile("":"+v"(negm)); \
        const float f=__builtin_amdgcn_exp2f(-dl); l_reg*=f; if(hi==0)wsf[r32]=f; resc=true; } } \
    SBAR(); \
    GAPB(o[0]=__builtin_amdgcn_mfma_f32_32x32x16_bf16(PAF(0),VFR(0),o[0],0,0,0), C0,0); \
    GAPB(o[1]=__builtin_amdgcn_mfma_f32_32x32x16_bf16(PAF(0),VFR(4),o[1],0,0,0), C0,4); \
    KRD(GL,0); GAPB(o[0]=__builtin_amdgcn_mfma_f32_32x32x16_bf16(PAF(1),VFR(1),o[0],0,0,0), C0,8); \
    KRD(GL,1); GAPB(o[1]=__builtin_amdgcn_mfma_f32_32x32x16_bf16(PAF(1),VFR(5),o[1],0,0,0), C0,12); \
    KRD(GL,2); GAPB(o[0]=__builtin_amdgcn_mfma_f32_32x32x16_bf16(PAF(2),VFR(2),o[0],0,0,0), C1,0); \
    KRD(GL,3); GAPB(o[1]=__builtin_amdgcn_mfma_f32_32x32x16_bf16(PAF(2),VFR(6),o[1],0,0,0), C1,4); \
    GAPB(o[0]=__builtin_amdgcn_mfma_f32_32x32x16_bf16(PAF(3),VFR(3),o[0],0,0,0), C1,8); \
    GAPB(o[1]=__builtin_amdgcn_mfma_f32_32x32x16_bf16(PAF(3),VFR(7),o[1],0,0,0), C1,12); \
    }while(0)
  int t=1;
  #undef CMASK
  #define CMASK(P0,P1,t) do{}while(0)
  for(;t+5<NT;t+=2){
    STEP(pB0,pB1,pA0,pA1,t,true,true,true);     WAIT_BAR(2); RESC(); ROT();
    STEP(pA0,pA1,pB0,pB1,t+1,true,true,true);   WAIT_BAR(2); RESC(); ROT();
  }
  #undef CMASK
  #define CMASK(P0,P1,t) do{int jb_=(t)-(NT-4); if(jb_>=0)cmask(P0,P1,jb_,qrel,hi);}while(0)
  #define ENDW(tt) do{ if((tt)+3<NT){WAIT_BAR(2);} else if((tt)+2<NT){WAIT_BAR(1);} else {WAIT_BAR(0);} }while(0)
  for(;t+1<NT;t+=2){
    STEP(pB0,pB1,pA0,pA1,t,(t+3<NT),(t+1<NT),(t+1<NT));       ENDW(t);   RESC(); ROT();
    STEP(pA0,pA1,pB0,pB1,t+1,(t+4<NT),(t+2<NT),(t+2<NT));     ENDW(t+1); RESC(); ROT();
  }
  STEP(pB0,pB1,pA0,pA1,NT-1,false,false,false); RESC();
  { float sacc=pB0[0]+pB0[1]; _Pragma("unroll") for(int r=2;r<16;++r)sacc+=pB0[r]; _Pragma("unroll") for(int r=0;r<16;++r)sacc+=pB1[r]; l_reg+=sacc;
    pw0=(u32x4){PKW(pB0,0),PKW(pB0,2),PKW(pB0,4),PKW(pB0,6)};pw1=(u32x4){PKW(pB0,8),PKW(pB0,10),PKW(pB0,12),PKW(pB0,14)};pw2=(u32x4){PKW(pB1,0),PKW(pB1,2),PKW(pB1,4),PKW(pB1,6)};pw3=(u32x4){PKW(pB1,8),PKW(pB1,10),PKW(pB1,12),PKW(pB1,14)};
    SBAR(); pv(o,vb0+sl_cur,PAF(0),PAF(1),PAF(2),PAF(3)); }
  #undef PKW
  #undef PAF
  #undef VFR
  #undef PIN
  #undef MX3
  #undef GAPA
  #undef GAPB
  #undef EX
  #undef VRD
  #undef KRD
  #undef STEP
  #undef ENDW
  {auto rr=__builtin_amdgcn_permlane32_swap(__float_as_uint(l_reg),__float_as_uint(l_reg),false,false);l_reg=__uint_as_float(rr[0])+__uint_as_float(rr[1]);}
  if(hi==0)wsf[32+r32]=l_reg;asm volatile("s_waitcnt lgkmcnt(0)":::"memory");
  float rli[16];
  #pragma unroll
  for(int r=0;r<16;++r)rli[r]=__builtin_amdgcn_rcpf(wsf[32+crow(r,hi)]);
  bf16*Ow=O+(rowbase+q0+wid*QBLK)*PO+ooff;
  { bf16*stg=(bf16*)(shm+LDS_OST)+wid*2048;
    #pragma unroll
    for(int r=0;r<16;++r){const int orow=crow(r,hi);
      #pragma unroll
      for(int d0=0;d0<2;++d0)stg[orow*64+d0*32+r32]=__float2bfloat16(o[d0][r]*rli[r]);}
    asm volatile("s_waitcnt lgkmcnt(0)":::"memory");
    #pragma unroll
    for(int i=0;i<4;++i){const int row=i*8+(lane>>3),ch=lane&7; const u32x4 v=*(const u32x4*)(stg+row*64+ch*8); ATTN_STORE16(Ow+(long)row*PO+ch*8,v);} }
  asm volatile("s_waitcnt lgkmcnt(0)\n\ts_barrier":::"memory");
  #undef DMA_K
  #undef DMA_V
  #undef CMASK
  #undef START
  #undef RESC
  #undef ROT
}
constexpr int ATTN_LDS_BYTES=LDS_BYTES;
struct AttnTensors { const bf16* Q; const bf16* K; const bf16* V; bf16* O; };
struct AttnUnit { int bh; int qb; };
struct StaticOrder {
  int vcu;
  __device__ __forceinline__ explicit StaticOrder(int grid,int block):vcu((block%8)*(grid/8)+block/8){}
  __device__ __forceinline__ bool next(int i,AttnUnit&u)const{ if(i>=4)return false; const int s=vcu&7; u.bh=vcu>>3; u.qb=(i==0)?s:(i==1)?15-s:(i==2)?16+s:31-s; return true; }
  __device__ __forceinline__ void a_ready(const AttnUnit&)const{}
  __device__ __forceinline__ void done(const AttnUnit&)const{}
};
template<class Sched,int THRL=8> __device__ __forceinline__ void attn_phase(char*lds,const AttnTensors&T,const Sched&S){
  AttnUnit u;
  for(int i=0;S.next(i,u);++i){ S.a_ready(u); const int b=u.bh/NHEAD, vh=u.bh%NHEAD, hh=vh>>2, mi=(vh>>1)&1, vj=vh&1; attn_unit<THRL>(b,hh*128+mi*64,hh*128+mi*64,hh*128+vj*64,mi*512+hh*128+vj*64,u.qb,T.Q,T.K,T.V,T.O,lds); S.done(u); }
}
#undef SBAR
#undef WAIT_BAR
}

constexpr int NWAVES = 8;
constexpr int DM = 1024, TSEQ = 8192, NBATCH = 2, MP = NBATCH * TSEQ, MS = 128, MTOT = MP + MS, MROWS = 16640;
constexpr int LW = 512, AW = 512, INW = 2560, FF = 2816, GU = 2 * FF, PLE = 256, NPAGE = 16, PAGE = 128, PASTLEN = 2048;
constexpr float LAM_INIT = 0.2f, SUBLN_SCALE = 0.8f;
constexpr float C2 = 0.125f * 1.4426950408889634f;
constexpr int CHUNK = 64, NCHUNK = MP / CHUNK;

constexpr size_t OY_P = 0, OY_S = OY_P + (size_t)MP * DM, OK_P = OY_S + (size_t)MS * DM, OV_P = OK_P + (size_t)MP * AW, OC_P = OV_P + (size_t)MP * AW,
                 OH_P = OC_P + (size_t)NBATCH * 3 * LW, OK_S = OH_P + (size_t)NBATCH * LW, OV_S = OK_S + (size_t)MS * AW, OC_S = OV_S + (size_t)MS * AW,
                 OH_S = OC_S + (size_t)MS * 3 * LW, OUT_TOTAL = OH_S + (size_t)MS * LW;
static_assert(OUT_TOTAL == 34082816, "d_out map");

constexpr size_t MiB = 1u << 20;
constexpr size_t al4k(size_t x) { return (x + 4095) & ~(size_t)4095; }
constexpr size_t WS_CTL = 0, CTL_ZERO_BYTES = 1 * MiB;
constexpr size_t WS_WIN  = 1 * MiB;
constexpr size_t WS_WOUT = WS_WIN  + al4k((size_t)INW * DM * 2);
constexpr size_t WS_WGU  = WS_WOUT + al4k((size_t)DM * DM * 2);
constexpr size_t WS_WD   = WS_WGU  + al4k((size_t)GU * DM * 2);
constexpr size_t WS_WPG  = WS_WD   + al4k((size_t)DM * FF * 2);
constexpr size_t WS_WPP  = WS_WPG  + al4k((size_t)DM * DM * 2);
constexpr size_t WS_WLRU = WS_WPP  + al4k((size_t)DM * PLE * 2);
constexpr size_t WS_ROPE = WS_WLRU + al4k((size_t)2 * 8 * 64 * 64 * 2);
constexpr size_t WS_XN   = WS_ROPE + al4k((size_t)TSEQ * 16 * 4);
constexpr size_t WS_PB   = WS_XN   + al4k((size_t)MROWS * DM * 2);
constexpr size_t WS_XL   = WS_PB   + al4k((size_t)MROWS * PLE * 2);
constexpr size_t WS_GG   = WS_XL   + al4k((size_t)MP * LW * 4);
constexpr size_t WS_Q    = WS_GG   + al4k((size_t)MP * LW * 2);
constexpr size_t WS_K    = WS_Q    + al4k((size_t)MP * AW * 2);
constexpr size_t WS_V    = WS_K    + al4k((size_t)MP * AW * 2);
constexpr size_t WS_O    = WS_V    + al4k((size_t)MP * AW * 2);
constexpr size_t WS_HL   = WS_O    + al4k((size_t)MP * 2 * AW * 2);
constexpr size_t WS_PC   = WS_HL   + al4k((size_t)MP * LW * 4);
constexpr size_t WS_CHS  = WS_PC   + al4k((size_t)MP * LW * 4);
constexpr size_t WS_AMIX = WS_CHS  + al4k((size_t)NCHUNK * 2 * LW * 4);
constexpr size_t WS_MIX  = WS_AMIX + al4k((size_t)MROWS * DM * 2);
constexpr size_t WS_X1   = WS_MIX  + al4k((size_t)MROWS * DM * 4);
constexpr size_t WS_HB   = WS_X1   + al4k((size_t)MROWS * DM * 4);
constexpr size_t WS_PROJ = WS_HB   + al4k((size_t)MP * FF * 2);
constexpr size_t WS_US   = WS_PROJ + al4k((size_t)MP * DM * 2);
constexpr size_t WS_GUS  = WS_US   + al4k((size_t)MS * INW * 4);
constexpr size_t WS_GS   = WS_GUS  + al4k((size_t)MS * GU * 4);
constexpr size_t WS_PJS  = WS_GS   + al4k((size_t)MS * DM * 4);
constexpr size_t WS_QS   = WS_PJS  + al4k((size_t)MS * DM * 4);
constexpr size_t DP_STRIDE = 2 * 132;
constexpr size_t WS_DP   = WS_QS   + al4k((size_t)MS * AW * 4);
constexpr size_t WS_END  = WS_DP   + al4k((size_t)MS * 2 * 4 * DP_STRIDE * 4);
constexpr int CW_TMO = 0, CW_CODE = 1, CW_DBG = 64;
constexpr int CW_QDEC = 128, CW_QATT = 192;
constexpr int CW_BAR = 4096;

constexpr int RING_OFF = 0, RING_BYTES = 131072;
constexpr int LDSCTL_OFF = RING_BYTES, MISC_OFF = LDSCTL_OFF + 320;
constexpr int LDS_BYTES = 147456;
static_assert(MISC_OFF + 128 <= LDS_BYTES, "LDS map");

#define GAS __attribute__((address_space(1)))
#define LAS __attribute__((address_space(3)))
typedef unsigned short bf16;
typedef unsigned v4u __attribute__((ext_vector_type(4)));
typedef float f32x4 __attribute__((ext_vector_type(4)));
typedef short bf16x8 __attribute__((ext_vector_type(8)));
typedef GAS unsigned gu32;
typedef GAS unsigned long long gu64;
#define RLX_AGENT __ATOMIC_RELAXED, __HIP_MEMORY_SCOPE_AGENT
#define LDS_WAIT() asm volatile("s_waitcnt lgkmcnt(0)" ::: "memory")
#define VM_WAIT() asm volatile("s_waitcnt vmcnt(0)" ::: "memory")
__device__ __forceinline__ unsigned long long rt() { return __builtin_amdgcn_s_memrealtime(); }
__device__ __forceinline__ unsigned f2bf(float f) { unsigned u = __builtin_bit_cast(unsigned, f); return (u + 0x7fffu + ((u >> 16) & 1u)) >> 16; }
__device__ __forceinline__ unsigned pk2(float lo, float hi) { return f2bf(lo) | (f2bf(hi) << 16); }

#define XB_TMO      128
#define XB_XCNT(j)  (256  + 64 * (j))
#define XB_XSUB(j)  (1280 + 64 * (j))
#define XB_XGEN(j)  (2304 + 64 * (j))
#define XB_TOP      3328
#define XB_TOPGEN   3392
#define XCD_BAR_WORDS 3456
#define XB_SPIN_CAP (1u << 18)

__device__ __forceinline__ unsigned xb_ld(unsigned* p)              { return __hip_atomic_load(p, __ATOMIC_RELAXED, __HIP_MEMORY_SCOPE_AGENT); }
__device__ __forceinline__ unsigned xb_add(unsigned* p, unsigned v) { return __hip_atomic_fetch_add(p, v, __ATOMIC_RELAXED, __HIP_MEMORY_SCOPE_AGENT); }
__device__ __forceinline__ unsigned xb_xcc_id() { return (unsigned)__builtin_amdgcn_s_getreg((3 << 11) | 20) & 0xFu; }
#define XB_SPIN(cond, bar) do { unsigned _sp = 0; while (cond) { __builtin_amdgcn_s_sleep(1); \
    if ((++_sp & 255u) == 0u) { if (xb_ld(&(bar)[XB_TMO])) break; if (_sp > XB_SPIN_CAP) { atomicAdd(&(bar)[XB_TMO], 1u); break; } } } } while (0)

struct XcdBarrier {
    unsigned* bar; unsigned x;
    volatile LAS unsigned* st;
};

__device__ __forceinline__ XcdBarrier xcd_barrier_post(unsigned* bar, volatile LAS unsigned* st) {
    XcdBarrier b; b.bar = bar; b.x = xb_xcc_id(); b.st = st;
    if (threadIdx.x == 0) (void)xb_add(&bar[XB_XCNT(b.x)], 1u);
    return b;
}
__device__ __forceinline__ void xcd_barrier_complete(unsigned* bar, unsigned x, unsigned& nloc, unsigned& nx) {
    const unsigned G = gridDim.x * gridDim.y * gridDim.z;
    unsigned sum, cnt, mine, sp = 0u;
    for (;;) {
        sum = 0u; cnt = 0u; mine = 0u;
#pragma unroll
        for (unsigned j = 0; j < 16; ++j) { const unsigned c = xb_ld(&bar[XB_XCNT(j)]); sum += c; cnt += (c > 0u) ? 1u : 0u; mine = (j == x) ? c : mine; }
        if (sum == G) break;
        __builtin_amdgcn_s_sleep(1);
        if ((++sp & 255u) == 0u) { if (xb_ld(&bar[XB_TMO])) break; if (sp > XB_SPIN_CAP) { atomicAdd(&bar[XB_TMO], 1u); break; } }
    }
    nloc = mine > 0u ? mine : 1u; nx = cnt > 0u ? cnt : 1u;
}

__device__ __forceinline__ void xcd_barrier(const XcdBarrier& b) {
    asm volatile("s_waitcnt vmcnt(0)" ::: "memory");
    __syncthreads();
    if (threadIdx.x == 0) {
        unsigned* bar = b.bar;
        __builtin_amdgcn_s_waitcnt(0);
        unsigned nloc = b.st[0], nx = b.st[1];
        if (nloc == 0u) { xcd_barrier_complete(bar, b.x, nloc, nx); b.st[0] = nloc; b.st[1] = nx; }
        const unsigned old = xb_add(&bar[XB_XSUB(b.x)], 1u);
        const unsigned gen = old / nloc;
        if (old + 1u == (gen + 1u) * nloc) {
            __builtin_amdgcn_fence(__ATOMIC_RELEASE, "agent");
            asm volatile("s_waitcnt vmcnt(0)" ::: "memory");
            const unsigned og = xb_add(&bar[XB_TOP], 1u);
            const unsigned tg = og / nx;
            if (og + 1u == (tg + 1u) * nx) xb_add(&bar[XB_TOPGEN], 1u);
            else XB_SPIN(xb_ld(&bar[XB_TOPGEN]) == tg, bar);
            __builtin_amdgcn_fence(__ATOMIC_ACQUIRE, "agent");
            xb_add(&bar[XB_XGEN(b.x)], 1u);
            asm volatile("s_waitcnt vmcnt(0)" ::: "memory");
        } else {
            XB_SPIN(xb_ld(&bar[XB_XGEN(b.x)]) == gen, bar);
            __builtin_amdgcn_fence(__ATOMIC_ACQUIRE, "agent");
            asm volatile("s_waitcnt vmcnt(0)" ::: "memory");
        }
    }
    __syncthreads();
}

typedef float f32x2g __attribute__((ext_vector_type(2)));
typedef unsigned u32x2g __attribute__((ext_vector_type(2)));
struct Frame {
    LAS unsigned char* lds;
    volatile LAS unsigned* MISC;
    gu32* ctl;
    int wave;
    int vcu, G;
    unsigned char* ws; float* out;

};
__device__ __forceinline__ float wave_sum(float v) {
#pragma unroll
    for (int o = 1; o < 64; o <<= 1) v += __shfl_xor(v, o);
    return v;
}
__device__ __forceinline__ float sigmoidf_(float x) { return __builtin_amdgcn_rcpf(1.f + __builtin_amdgcn_exp2f(-1.4426950408889634f * x)); }
__device__ __forceinline__ float gelu_tanh_(float x) { const float u = 1.5957691216057308f * (x + 0.044715f * x * x * x); return x * __builtin_amdgcn_rcpf(1.f + __builtin_amdgcn_exp2f(-1.4426950408889634f * u)); }
__device__ __forceinline__ float bf2f(unsigned short h) { return __builtin_bit_cast(float, (unsigned)h << 16); }

struct EpiIn {
    static constexpr bool PERM = true, AFTER_DRAIN = false;
    float* XL; bf16* GG; bf16* Q; bf16* K; bf16* V; float* kout; float* vout; const float* rope;
    __device__ __forceinline__ void operator()(const pg8::f32x4 (&acc)[2][2][4][2], const pg8::Unit& u, int wr, int wc, int fr, int fq) const {
        const int sec = u.pn >> 1;
        const int row0 = u.pm * 256 + wr * 64 + fr;
        const int cbase = (u.pn & 1) * 256 + wc * 32 + 8 * fq;
#pragma unroll
        for (int ai = 0; ai < 2; ++ai)
#pragma unroll
            for (int m = 0; m < 4; ++m) {
                const int row = row0 + ai * 128 + m * 16;
                f32x4 rc0, rc1, rs0, rs1;
                if ((sec == 2 || sec == 3) && !(wc & 1)) { const f32x4* rp = (const f32x4*)(rope + (size_t)(row & (TSEQ - 1)) * 16); rc0 = rp[0]; rc1 = rp[1]; rs0 = rp[2]; rs1 = rp[3]; }
#pragma unroll
                for (int bj = 0; bj < 2; ++bj) {
                    const int cs = cbase + bj * 128;
                    f32x4 v0 = acc[ai][bj][m][0], v1 = acc[ai][bj][m][1];
                    const size_t o = (size_t)row * 512 + cs;
                    if (sec == 0) { *(f32x4*)(XL + o) = v0; *(f32x4*)(XL + o + 4) = v1; }
                    else if (sec == 1) {
                        v4u w; w.x = pk2(gelu_tanh_(v0[0]), gelu_tanh_(v0[1])); w.y = pk2(gelu_tanh_(v0[2]), gelu_tanh_(v0[3])); w.z = pk2(gelu_tanh_(v1[0]), gelu_tanh_(v1[1])); w.w = pk2(gelu_tanh_(v1[2]), gelu_tanh_(v1[3]));
                        *(v4u*)(GG + o) = w; }
                    else {
                        if (sec != 4 && !(wc & 1)) {
                            f32x4 p0, p1;
#pragma unroll
                            for (int e = 0; e < 4; ++e) { p0[e] = __shfl_xor(v0[e], 16); p1[e] = __shfl_xor(v1[e], 16); }
                            if (fq == 0) { v0 = v0 * rc0 - p0 * rs0; v1 = v1 * rc1 - p1 * rs1; }
                            else if (fq == 1) { v0 = v0 * rc0 + p0 * rs0; v1 = v1 * rc1 + p1 * rs1; }
                        }
                        if (sec == 2) { v0 = v0 * C2; v1 = v1 * C2; v4u w; w.x = pk2(v0[0], v0[1]); w.y = pk2(v0[2], v0[3]); w.z = pk2(v1[0], v1[1]); w.w = pk2(v1[2], v1[3]); *(v4u*)(Q + o) = w; }
                        else { float* fo = (sec == 3 ? kout : vout) + o; *(f32x4*)fo = v0; *(f32x4*)(fo + 4) = v1;
                            v4u w; w.x = pk2(v0[0], v0[1]); w.y = pk2(v0[2], v0[3]); w.z = pk2(v1[0], v1[1]); w.w = pk2(v1[2], v1[3]); *(v4u*)((sec == 3 ? K : V) + o) = w; }
                    }
                }
            }
    }
};
struct EpiBf {
    static constexpr bool PERM = true, AFTER_DRAIN = false;
    bf16* O; int ldc;
    __device__ __forceinline__ void operator()(const pg8::f32x4 (&acc)[2][2][4][2], const pg8::Unit& u, int wr, int wc, int fr, int fq) const {
        const int row0 = u.pm * 256 + wr * 64 + fr, col0 = u.pn * 256 + wc * 32 + 8 * fq;
#pragma unroll
        for (int ai = 0; ai < 2; ++ai)
#pragma unroll
            for (int m = 0; m < 4; ++m)
#pragma unroll
                for (int bj = 0; bj < 2; ++bj) { const f32x4 v0 = acc[ai][bj][m][0], v1 = acc[ai][bj][m][1];
                    v4u w; w.x = pk2(v0[0], v0[1]); w.y = pk2(v0[2], v0[3]); w.z = pk2(v1[0], v1[1]); w.w = pk2(v1[2], v1[3]);
                    *(v4u*)(O + (size_t)(row0 + ai * 128 + m * 16) * ldc + col0 + bj * 128) = w; }
    }
};
struct EpiF32 {
    static constexpr bool PERM = true, AFTER_DRAIN = false;
    float* O; int ldc;
    __device__ __forceinline__ void operator()(const pg8::f32x4 (&acc)[2][2][4][2], const pg8::Unit& u, int wr, int wc, int fr, int fq) const {
        const int row0 = u.pm * 256 + wr * 64 + fr, col0 = u.pn * 256 + wc * 32 + 8 * fq;
#pragma unroll
        for (int ai = 0; ai < 2; ++ai)
#pragma unroll
            for (int m = 0; m < 4; ++m)
#pragma unroll
                for (int bj = 0; bj < 2; ++bj) { float* p = O + (size_t)(row0 + ai * 128 + m * 16) * ldc + col0 + bj * 128; *(f32x4*)p = acc[ai][bj][m][0]; *(f32x4*)(p + 4) = acc[ai][bj][m][1]; }
    }
};
struct EpiSwiGlu {
    static constexpr bool PERM = true, AFTER_DRAIN = false;
    bf16* H;
    __device__ __forceinline__ void operator()(const pg8::f32x4 (&acc)[2][2][4][2], const pg8::Unit& u, int wr, int wc, int fr, int fq) const {
        const int row0 = u.pm * 256 + wr * 64 + fr, col0 = u.pn * 128 + wc * 32 + 8 * fq;
#pragma unroll
        for (int ai = 0; ai < 2; ++ai)
#pragma unroll
            for (int m = 0; m < 4; ++m) { const f32x4 g0 = acc[ai][0][m][0], g1 = acc[ai][0][m][1], u0 = acc[ai][1][m][0], u1 = acc[ai][1][m][1]; float h[8];
#pragma unroll
                for (int e = 0; e < 4; ++e) { h[e] = g0[e] * sigmoidf_(g0[e]) * u0[e]; h[4 + e] = g1[e] * sigmoidf_(g1[e]) * u1[e]; }
                v4u w; w.x = pk2(h[0], h[1]); w.y = pk2(h[2], h[3]); w.z = pk2(h[4], h[5]); w.w = pk2(h[6], h[7]);
                *(v4u*)(H + (size_t)(row0 + ai * 128 + m * 16) * FF + col0) = w; }
    }
};
struct EpiPle {
    static constexpr bool PERM = true, AFTER_DRAIN = false;
    const bf16* P; float* O;
    __device__ __forceinline__ void operator()(const pg8::f32x4 (&acc)[2][2][4][2], const pg8::Unit& u, int wr, int wc, int fr, int fq) const {
        const int row0 = u.pm * 256 + wr * 64 + fr, col0 = u.pn * 256 + wc * 32 + 8 * fq;
#pragma unroll
        for (int ai = 0; ai < 2; ++ai)
#pragma unroll
            for (int m = 0; m < 4; ++m)
#pragma unroll
                for (int bj = 0; bj < 2; ++bj) { const size_t o = (size_t)(row0 + ai * 128 + m * 16) * DM + col0 + bj * 128; const v4u pw = *(const v4u*)(P + o);
                    const f32x4 v0 = acc[ai][bj][m][0], v1 = acc[ai][bj][m][1]; f32x4 r0, r1;
                    r0[0] = sigmoidf_(v0[0]) * bf2f((unsigned short)(pw.x & 0xffff)); r0[1] = sigmoidf_(v0[1]) * bf2f((unsigned short)(pw.x >> 16));
                    r0[2] = sigmoidf_(v0[2]) * bf2f((unsigned short)(pw.y & 0xffff)); r0[3] = sigmoidf_(v0[3]) * bf2f((unsigned short)(pw.y >> 16));
                    r1[0] = sigmoidf_(v1[0]) * bf2f((unsigned short)(pw.z & 0xffff)); r1[1] = sigmoidf_(v1[1]) * bf2f((unsigned short)(pw.z >> 16));
                    r1[2] = sigmoidf_(v1[2]) * bf2f((unsigned short)(pw.w & 0xffff)); r1[3] = sigmoidf_(v1[3]) * bf2f((unsigned short)(pw.w >> 16));
                    *(f32x4*)(O + o) = r0; *(f32x4*)(O + o + 4) = r1; }
    }
};

template <int AMODE> __device__ __forceinline__ bf16x8 sg_load_a(const void* A, int lda, int row, int k) {
    if constexpr (AMODE == 0) { return *(const bf16x8*)((const bf16*)A + (size_t)row * lda + k); }
    else { const float* g = (const float*)A + (size_t)row * GU + (k >> 7) * 256 + (k & 127); const f32x4 g0 = *(const f32x4*)g, g1 = *(const f32x4*)(g + 4), u0 = *(const f32x4*)(g + 128), u1 = *(const f32x4*)(g + 132);
        v4u w; w.x = pk2(g0[0] * sigmoidf_(g0[0]) * u0[0], g0[1] * sigmoidf_(g0[1]) * u0[1]); w.y = pk2(g0[2] * sigmoidf_(g0[2]) * u0[2], g0[3] * sigmoidf_(g0[3]) * u0[3]);
        w.z = pk2(g1[0] * sigmoidf_(g1[0]) * u1[0], g1[1] * sigmoidf_(g1[1]) * u1[1]); w.w = pk2(g1[2] * sigmoidf_(g1[2]) * u1[2], g1[3] * sigmoidf_(g1[3]) * u1[3]);
        return __builtin_bit_cast(bf16x8, w); }
}
template <int AMODE> __device__ __forceinline__ void small_gemm(Frame& F, const void* A, int lda, const bf16* Bt, int N, int K, float* C, int ldc) {
    LAS float* part = (LAS float*)(F.lds + RING_OFF);
    const int lane = lane_now(), tid = F.wave * 64 + lane, w = F.wave, fr = lane & 15, fq = lane >> 4;
    const int nitems = 8 * (N / 32), kw = K / 8;
    for (int it = F.G - 1 - (int)blockIdx.x; it < nitems; it += F.G) {
        const int row0 = (it & 7) * 16, col0 = (it >> 3) * 32;
        f32x4 acc0 = {0.f, 0.f, 0.f, 0.f}, acc1 = {0.f, 0.f, 0.f, 0.f};
        const int kbeg = w * kw;
        const bf16* b0p = Bt + (size_t)(col0 + fr) * K + 8 * fq; const bf16* b1p = b0p + (size_t)16 * K;
#pragma unroll 4
        for (int k = kbeg; k < kbeg + kw; k += 32) {
            const bf16x8 a = sg_load_a<AMODE>(A, lda, row0 + fr, k + 8 * fq);
            const bf16x8 b0 = *(const bf16x8*)(b0p + k), b1 = *(const bf16x8*)(b1p + k);
            acc0 = __builtin_amdgcn_mfma_f32_16x16x32_bf16(a, b0, acc0, 0, 0, 0);
            acc1 = __builtin_amdgcn_mfma_f32_16x16x32_bf16(a, b1, acc1, 0, 0, 0);
        }
#pragma unroll
        for (int r = 0; r < 4; ++r) { part[((w * 2 + 0) * 4 + r) * 64 + lane] = acc0[r]; part[((w * 2 + 1) * 4 + r) * 64 + lane] = acc1[r]; }
        __syncthreads();
        { const int r = tid >> 5, n = tid & 31, c = n >> 4, ln = (n & 15) + 16 * (r >> 2), rg = r & 3; float s = 0.f;
#pragma unroll
          for (int w2 = 0; w2 < 8; ++w2) s += part[((w2 * 2 + c) * 4 + rg) * 64 + ln];
          C[(size_t)(row0 + r) * ldc + col0 + n] = s; }
        __syncthreads();
    }
}

__device__ __forceinline__ void p0_transpose_item(const float* W, int N, bf16* WT, int ldt, int k0, int n0, int dst_row, LAS float* scr, int lane) {
#pragma unroll 8
    for (int i = 0; i < 32; ++i) { const int kk = 2 * i + (lane >> 5); scr[kk * 33 + (lane & 31)] = W[(size_t)(k0 + kk) * N + n0 + (lane & 31)]; }
    LDS_WAIT(); asm volatile("" ::: "memory");
    const int c = lane & 7;
#pragma unroll
    for (int j = 0; j < 4; ++j) { const int n = (lane >> 3) + 8 * j; const LAS float* s = scr + (8 * c) * 33 + n;
        v4u o; o.x = pk2(s[0 * 33], s[1 * 33]); o.y = pk2(s[2 * 33], s[3 * 33]); o.z = pk2(s[4 * 33], s[5 * 33]); o.w = pk2(s[6 * 33], s[7 * 33]);
        *(GAS v4u*)(WT + (size_t)(dst_row + n) * ldt + k0 + 8 * c) = o; }
    LDS_WAIT(); asm volatile("" ::: "memory");
}
__device__ __forceinline__ void row_load(const float* xrow, int lane, f32x4 (&v)[4]) {
    const GAS f32x4* xr = (const GAS f32x4*)xrow + lane;
#pragma unroll
    for (int j = 0; j < 4; ++j) v[j] = xr[64 * j];
}
__device__ __forceinline__ float row_ssq(const f32x4 (&v)[4]) { float s = 0.f;
#pragma unroll
    for (int j = 0; j < 4; ++j) s += (v[j].x * v[j].x + v[j].y * v[j].y) + (v[j].z * v[j].z + v[j].w * v[j].w);
    return wave_sum(s); }
__device__ __forceinline__ void row_store_bf16(bf16* orow, int lane, const f32x4 (&v)[4]) {
    GAS unsigned long long* o8 = (GAS unsigned long long*)orow + lane;
#pragma unroll
    for (int j = 0; j < 4; ++j) o8[64 * j] = (unsigned long long)pk2(v[j].x, v[j].y) | ((unsigned long long)pk2(v[j].z, v[j].w) << 32);
}
__device__ __forceinline__ void row_store_f32(float* orow, int lane, const f32x4 (&v)[4]) {
    GAS f32x4* o = (GAS f32x4*)orow + lane;
#pragma unroll
    for (int j = 0; j < 4; ++j) o[64 * j] = v[j];
}

struct LruArgs {
    const float* XL; const float* conv_w; const float* conv_b; const bf16* WL; const float* ba; const float* bx; const float* Lp;
    float* HL; float* PC; float* CHS;
    const float* US; const float* sconv; const float* sh; float* hout; bf16* amix;
};
constexpr int LRU_XT = 19 * 64, LRU_AT = 16 * 64 / 2, LRU_G = 16 * 65, LRU_WAVE_F = LRU_XT + LRU_AT + 2 * LRU_G;
static_assert(LRU_WAVE_F * 4 * 8 <= RING_BYTES, "LRU LDS");
__device__ __forceinline__ float expm1_neg_(float x) {
    const float t = x * (1.f + x * (0.5f + x * (0.16666667f + x * (0.041666668f + x * (0.0083333338f + x * 0.0013888889f)))));
    const float e = __builtin_amdgcn_exp2f(x * 1.4426950408889634f) - 1.f;
    return x > -0.3f ? t : e;
}
template <bool SAMPLE> __device__ __forceinline__ void lru_unit(Frame& F, const LruArgs& A, int unit) {
    const int lane = lane_now(), n = F.wave, i16 = lane & 15, kq = lane >> 4;
    LAS float* XT = (LAS float*)(F.lds + RING_OFF) + n * LRU_WAVE_F;
    LAS unsigned short* AT = (LAS unsigned short*)(XT + LRU_XT);
    LAS float* RR = XT + LRU_XT + LRU_AT; LAS float* IG = RR + LRU_G;
    bf16x8 bR[4][2], bI[4][2];
#pragma unroll
    for (int nt = 0; nt < 4; ++nt)
#pragma unroll
        for (int ks = 0; ks < 2; ++ks) { const size_t o = (size_t)n * 4096 + (size_t)(16 * nt + i16) * 64 + 32 * ks + 8 * kq; bR[nt][ks] = *(const bf16x8*)(A.WL + o); bI[nt][ks] = *(const bf16x8*)(A.WL + 32768 + o); }
    float bar_[4], bxr_[4];
#pragma unroll
    for (int nt = 0; nt < 4; ++nt) { bar_[nt] = A.ba[64 * n + 16 * nt + i16]; bxr_[nt] = A.bx[64 * n + 16 * nt + i16]; }
    const int chl = 64 * n + lane;
    const float sp8 = -8.f * log1pf(expf(-A.Lp[chl]));
    const float cw0 = A.conv_w[chl], cw1 = A.conv_w[LW + chl], cw2 = A.conv_w[2 * LW + chl], cw3 = A.conv_w[3 * LW + chl], cb = A.conv_b[chl];
    float hl = 0.f, pc = 1.f;
    constexpr int NSTEP = SAMPLE ? 1 : 4;
    const int r0 = unit * (SAMPLE ? 16 : 64);
    const int t0 = SAMPLE ? 0 : (r0 & (TSEQ - 1));
    f32x4 xs[5];
    auto xt_load = [&](int mt) {
#pragma unroll
        for (int j = 0; j < 5; ++j) { const int p = lane + 64 * j, rw = p >> 4, c4 = p & 15; const int tr = 16 * mt - 3 + rw;
            if (p < 304 && t0 + tr >= 0) xs[j] = *(const f32x4*)(A.XL + (size_t)(r0 + tr) * LW + 64 * n + 4 * c4); else xs[j] = (f32x4){0.f, 0.f, 0.f, 0.f}; } };
    if (!SAMPLE) xt_load(0);
    for (int mt = 0; mt < NSTEP; ++mt) {
        float xc[16];
        if (SAMPLE) {
            float xv[16][4];
#pragma unroll
            for (int t = 0; t < 16; ++t) { const int b = r0 + t;
                xv[t][0] = A.sconv[((size_t)b * 3 + 0) * LW + chl]; xv[t][1] = A.sconv[((size_t)b * 3 + 1) * LW + chl]; xv[t][2] = A.sconv[((size_t)b * 3 + 2) * LW + chl]; xv[t][3] = A.US[(size_t)b * INW + chl]; }
#pragma unroll
            for (int t = 0; t < 16; ++t) xc[t] = cb + cw0 * xv[t][0] + cw1 * xv[t][1] + cw2 * xv[t][2] + cw3 * xv[t][3];
        } else {
#pragma unroll
            for (int j = 0; j < 5; ++j) { const int p = lane + 64 * j; if (p < 304) *(LAS f32x4*)(XT + (p >> 4) * 64 + 4 * (p & 15)) = xs[j]; }
            LDS_WAIT(); asm volatile("" ::: "memory");
            if (mt + 1 < NSTEP) xt_load(mt + 1);
#pragma unroll
            for (int t = 0; t < 16; ++t) xc[t] = cb + cw0 * XT[t * 64 + lane] + cw1 * XT[(t + 1) * 64 + lane] + cw2 * XT[(t + 2) * 64 + lane] + cw3 * XT[(t + 3) * 64 + lane];
        }
#pragma unroll
        for (int t = 0; t < 16; ++t) AT[t * 64 + lane] = (unsigned short)f2bf(xc[t]);
        LDS_WAIT(); asm volatile("" ::: "memory");
        bf16x8 afr[2];
#pragma unroll
        for (int ks = 0; ks < 2; ++ks) afr[ks] = *(const LAS bf16x8*)(AT + i16 * 64 + 32 * ks + 8 * kq);
#pragma unroll
        for (int nt = 0; nt < 4; ++nt) {
            f32x4 aR = {0.f, 0.f, 0.f, 0.f}, aI = {0.f, 0.f, 0.f, 0.f};
#pragma unroll
            for (int ks = 0; ks < 2; ++ks) { aR = __builtin_amdgcn_mfma_f32_16x16x32_bf16(afr[ks], bR[nt][ks], aR, 0, 0, 0); aI = __builtin_amdgcn_mfma_f32_16x16x32_bf16(afr[ks], bI[nt][ks], aI, 0, 0, 0); }
#pragma unroll
            for (int r = 0; r < 4; ++r) { RR[(4 * kq + r) * 65 + 16 * nt + i16] = sigmoidf_(aR[r] + bar_[nt]); IG[(4 * kq + r) * 65 + 16 * nt + i16] = sigmoidf_(aI[r] + bxr_[nt]); }
        }
        LDS_WAIT(); asm volatile("" ::: "memory");
#pragma unroll
        for (int tl = 0; tl < 16; ++tl) {
            const float rr = RR[tl * 65 + lane], gg = IG[tl * 65 + lane];
            const float la = rr * sp8, a = __builtin_amdgcn_exp2f(la * 1.4426950408889634f), bt = __builtin_amdgcn_sqrtf(-expm1_neg_(2.f * la)) * (gg * xc[tl]);
            const int row = r0 + 16 * mt + tl;
            if (SAMPLE) { const float h = a * A.sh[(size_t)row * LW + chl] + bt; A.hout[(size_t)row * LW + chl] = h;
                const float g = A.US[(size_t)row * INW + LW + chl]; A.amix[(size_t)(MP + row) * DM + chl] = (bf16)f2bf(h * gelu_tanh_(g)); }
            else { hl = a * hl + bt; pc *= a; A.HL[(size_t)row * LW + chl] = hl; A.PC[(size_t)row * LW + chl] = pc; }
        }
        LDS_WAIT(); asm volatile("" ::: "memory");
    }
    if (!SAMPLE) { A.CHS[(size_t)unit * 2 * LW + chl] = pc; A.CHS[(size_t)unit * 2 * LW + LW + chl] = hl; }
}

struct DecArgs { const float* US; const float* rope; const float* ck; const float* cv; const int* pt; float* ksout; float* vsout; float* QS; float* DP; };
__device__ __forceinline__ float row16_sum(float v) {
    v += __shfl_xor(v, 1); v += __shfl_xor(v, 2); v += __shfl_xor(v, 4); v += __shfl_xor(v, 8); return v;
}
__device__ __forceinline__ void decode_unit(Frame& F, const DecArgs& A, int b, int split) {
    LAS float* qs = (LAS float*)(F.lds + RING_OFF);
    LAS float* racc = qs + 512;
    LAS float* rml = racc + 8 * 8 * 64;
    const int lane = lane_now();
    { const int cs = F.wave * 64 + lane, d = cs & 63; const float* ub = A.US + (size_t)b * INW;
      float qv = ub[1024 + cs], kv = ub[1536 + cs];
      if (d < 16) { const int i = d & 7, pc = d < 8 ? cs + 8 : cs - 8; const float c = A.rope[(size_t)PASTLEN * 16 + i], s = A.rope[(size_t)PASTLEN * 16 + 8 + i];
          const float qp = ub[1024 + pc], kp = ub[1536 + pc];
          if (d < 8) { qv = qv * c - qp * s; kv = kv * c - kp * s; } else { qv = qv * c + qp * s; kv = kv * c + kp * s; } }
      qs[cs] = qv * C2;
      if (split == 0) { A.QS[(size_t)b * AW + cs] = qv * C2; A.ksout[(size_t)b * AW + cs] = kv; A.vsout[(size_t)b * AW + cs] = ub[2048 + cs]; } }
    __syncthreads();
    const int w = F.wave, hp = w & 1, sub = w >> 1;
    const int head = 2 * hp + (lane >> 5), e4 = 4 * (lane & 31);
    const bool map0 = ((lane >> 4) & 1) == 0;
    const f32x4 q = *(const LAS f32x4*)(qs + head * 128 + e4);
    float m = -1e30f, l = 0.f; f32x4 a1 = {0.f, 0.f, 0.f, 0.f}, a2 = {0.f, 0.f, 0.f, 0.f};
    for (int pg = 0; pg < 2; ++pg) {
        const int page = __builtin_amdgcn_readfirstlane(A.pt[b * NPAGE + split * 8 + sub * 2 + pg]);
        const float* kb = A.ck + (size_t)page * (PAGE * 512) + head * 128 + e4;
        const float* vb = A.cv + (size_t)page * (PAGE * 512) + head * 128 + e4;
        for (int s0 = 0; s0 < PAGE; s0 += 8) {
            f32x4 kk[8], vv[8];
#pragma unroll
            for (int j = 0; j < 8; ++j) { kk[j] = __builtin_nontemporal_load((const f32x4*)(kb + (size_t)(s0 + j) * 512)); vv[j] = __builtin_nontemporal_load((const f32x4*)(vb + (size_t)(s0 + j) * 512)); }
            float sc[8]; float mx = -1e30f;
#pragma unroll
            for (int j = 0; j < 8; ++j) { sc[j] = row16_sum((q[0] * kk[j][0] + q[1] * kk[j][1]) + (q[2] * kk[j][2] + q[3] * kk[j][3])); mx = fmaxf(mx, sc[j]); }
            const float mn = fmaxf(m, mx), corr = __builtin_amdgcn_exp2f(m - mn); m = mn;
            float p[8], ps = 0.f;
#pragma unroll
            for (int j = 0; j < 8; ++j) { p[j] = __builtin_amdgcn_exp2f(sc[j] - mn); ps += p[j]; }
            l = l * corr + ps;
            const float corr_o = __shfl_xor(corr, 16);
            const float c1 = map0 ? corr : corr_o, c2 = map0 ? corr_o : corr;
            a1 = a1 * c1; a2 = a2 * c2;
#pragma unroll
            for (int j = 0; j < 8; ++j) { const float po = __shfl_xor(p[j], 16); const float p1 = map0 ? p[j] : po, p2 = map0 ? po : p[j]; a1 += vv[j] * p1; a2 += vv[j] * p2; }
        }
    }
#pragma unroll
    for (int e = 0; e < 4; ++e) { racc[(w * 8 + e) * 64 + lane] = a1[e]; racc[(w * 8 + 4 + e) * 64 + lane] = a2[e]; }
    rml[(w * 2 + 0) * 64 + lane] = m; rml[(w * 2 + 1) * 64 + lane] = l;
    __syncthreads();
    if (w < 2) {
        const int l1 = lane & ~16, l2 = lane | 16;
        float M1 = -1e30f, M2 = -1e30f;
#pragma unroll
        for (int s = 0; s < 4; ++s) { const int wv = hp + 2 * s; M1 = fmaxf(M1, rml[(wv * 2) * 64 + l1]); M2 = fmaxf(M2, rml[(wv * 2) * 64 + l2]); }
        float L1 = 0.f, L2 = 0.f; f32x4 o1 = {0.f, 0.f, 0.f, 0.f}, o2 = {0.f, 0.f, 0.f, 0.f};
#pragma unroll
        for (int s = 0; s < 4; ++s) { const int wv = hp + 2 * s;
            const float w1 = __builtin_amdgcn_exp2f(rml[(wv * 2) * 64 + l1] - M1), w2 = __builtin_amdgcn_exp2f(rml[(wv * 2) * 64 + l2] - M2);
            L1 += rml[(wv * 2 + 1) * 64 + l1] * w1; L2 += rml[(wv * 2 + 1) * 64 + l2] * w2;
#pragma unroll
            for (int e = 0; e < 4; ++e) { o1[e] += racc[(wv * 8 + e) * 64 + lane] * w1; o2[e] += racc[(wv * 8 + 4 + e) * 64 + lane] * w2; } }
        float* dp = A.DP + ((size_t)(b * 2 + split) * 4 + head) * DP_STRIDE;
        *(f32x4*)(dp + e4) = o1; *(f32x4*)(dp + 132 + e4) = o2;
        if ((lane & 31) == 0) { dp[128] = M1; dp[129] = L1; dp[132 + 128] = M2; dp[132 + 129] = L2; }
    }
    __syncthreads();
}


#ifndef MK_N_LAUNCHES
#define MK_N_LAUNCHES 1
#endif
constexpr int N_PHASES = 11;
#ifndef REP_P0
#define REP_P0 1
#endif
#ifndef REP_P3
#define REP_P3 1
#endif
#ifndef REP_P5
#define REP_P5 1
#endif
#ifndef REP_P10
#define REP_P10 1
#endif
#ifndef REP_LRU
#define REP_LRU 1
#endif
struct Args { const void* in[33]; float* out; unsigned char* ws; float inv_freq[8]; int ph_lo, ph_hi, li, pad; };
enum { I_XP = 0, I_XS, I_CK, I_CV, I_SCONV, I_SH, I_PT, I_PP, I_PS, I_NPM, I_WIN, I_CONVW, I_CONVB, I_WA, I_BA, I_WX, I_BX, I_L, I_LQ1, I_LK1, I_LQ2, I_LK2, I_SUBG, I_WOUT, I_NPOSTM, I_NPREF,
       I_WG, I_WU, I_WD, I_NPOSTF, I_PWG, I_PWP, I_PNORM };

__global__ void __launch_bounds__(NWAVES * 64, 2) hymba_fwd(Args args) {
    extern __shared__ __attribute__((aligned(16))) unsigned char lds[];
    Frame F;
    F.lds = (LAS unsigned char*)lds;
    F.MISC = (volatile LAS unsigned*)(F.lds + MISC_OFF);
    F.wave = __builtin_amdgcn_readfirstlane((int)threadIdx.x >> 6);
    F.G = gridDim.x; { const int bx = blockIdx.x; F.vcu = (F.G % 8 == 0) ? (bx % 8) * (F.G / 8) + bx / 8 : bx; }
    F.ctl = (gu32*)(args.ws + WS_CTL);
#define INF(k) ((const float*)args.in[k])
#define WSB(off) ((bf16*)(args.ws + (off)))
#define WSF(off) ((float*)(args.ws + (off)))
#define WIN WSB(WS_WIN)
#define WOUT WSB(WS_WOUT)
#define WGU WSB(WS_WGU)
#define WD WSB(WS_WD)
#define WPG WSB(WS_WPG)
#define WPP WSB(WS_WPP)
#define WLRU WSB(WS_WLRU)
#define ROPE WSF(WS_ROPE)
#define XN WSB(WS_XN)
#define PB WSB(WS_PB)
#define XL WSF(WS_XL)
#define GG WSB(WS_GG)
#define QB_ WSB(WS_Q)
#define KB_ WSB(WS_K)
#define VB_ WSB(WS_V)
#define OB WSB(WS_O)
#define HL WSF(WS_HL)
#define PC WSF(WS_PC)
#define CHS WSF(WS_CHS)
#define AMIX WSB(WS_AMIX)
#define MIX WSF(WS_MIX)
#define X1 WSF(WS_X1)
#define HB WSB(WS_HB)
#define PROJ WSB(WS_PROJ)
#define US WSF(WS_US)
#define GUS WSF(WS_GUS)
#define GS WSF(WS_GS)
#define PJS WSF(WS_PJS)
#define QS WSF(WS_QS)
#define DP WSF(WS_DP)
    for (int u = threadIdx.x; u < (LDS_BYTES - LDSCTL_OFF) / 4; u += NWAVES * 64) ((LAS unsigned*)(F.lds + LDSCTL_OFF))[u] = 0u;
    __syncthreads();
    XcdBarrier bar; bar.bar = (unsigned*)(F.ctl + CW_BAR) + args.li * XCD_BAR_WORDS; bar.x = 0; bar.st = nullptr;
    if (args.ph_hi - args.ph_lo > 1) bar = xcd_barrier_post((unsigned*)(F.ctl + CW_BAR) + args.li * XCD_BAR_WORDS, F.MISC + 8);
    const int lo = args.ph_lo, hi = args.ph_hi;
#define IN(k) (lo <= (k) && (k) < hi)
#define BOTH(k) (IN(k) && IN((k) + 1))
#define GRID_BAR() xcd_barrier(bar)
    const int gw = F.vcu * NWAVES + F.wave, NGW = F.G * NWAVES;

    if (IN(0)) {
        const int lane = lane_now(), tid = F.wave * 64 + lane; (void)tid;
        for (int rep_ = 0; rep_ < REP_P0; ++rep_) {
        LAS float* scr = (LAS float*)(F.lds + RING_OFF + F.wave * 16384);
        constexpr int I_IN = (DM / 64) * (INW / 32), I_SQ = (DM / 64) * (DM / 32), I_G = (DM / 64) * (FF / 32), I_D = (FF / 64) * (DM / 32), I_P = (PLE / 64) * (DM / 32), I_LR = 8 * 2;
        constexpr int NITEMS = I_IN + I_SQ + 2 * I_G + I_D + I_SQ + I_P + 2 * I_LR;
        for (int it = gw; it < NITEMS; it += NGW) {
            int r = it;
            if (r < I_IN) { const int nb = INW / 32, kb = r / nb, n0 = 32 * (r % nb); p0_transpose_item(INF(I_WIN), INW, WIN, DM, 64 * kb, n0, n0, scr, lane); continue; } r -= I_IN;
            if (r < I_SQ) { const int nb = DM / 32, kb = r / nb, n0 = 32 * (r % nb); p0_transpose_item(INF(I_WOUT), DM, WOUT, DM, 64 * kb, n0, n0, scr, lane); continue; } r -= I_SQ;
            if (r < I_G) { const int nb = FF / 32, kb = r / nb, n0 = 32 * (r % nb); p0_transpose_item(INF(I_WG), FF, WGU, DM, 64 * kb, n0, 256 * (n0 >> 7) + (n0 & 127), scr, lane); continue; } r -= I_G;
            if (r < I_G) { const int nb = FF / 32, kb = r / nb, n0 = 32 * (r % nb); p0_transpose_item(INF(I_WU), FF, WGU, DM, 64 * kb, n0, 256 * (n0 >> 7) + 128 + (n0 & 127), scr, lane); continue; } r -= I_G;
            if (r < I_D) { const int nb = DM / 32, kb = r / nb, n0 = 32 * (r % nb); p0_transpose_item(INF(I_WD), DM, WD, FF, 64 * kb, n0, n0, scr, lane); continue; } r -= I_D;
            if (r < I_SQ) { const int nb = DM / 32, kb = r / nb, n0 = 32 * (r % nb); p0_transpose_item(INF(I_PWG), DM, WPG, DM, 64 * kb, n0, n0, scr, lane); continue; } r -= I_SQ;
            if (r < I_P) { const int nb = DM / 32, kb = r / nb, n0 = 32 * (r % nb); p0_transpose_item(INF(I_PWP), DM, WPP, PLE, 64 * kb, n0, n0, scr, lane); continue; } r -= I_P;
            if (r < I_LR) { const int blk = r >> 1, n0 = 32 * (r & 1); p0_transpose_item(INF(I_WA) + blk * 4096, 64, WLRU + blk * 4096, 64, 0, n0, n0, scr, lane); continue; } r -= I_LR;
            { const int blk = r >> 1, n0 = 32 * (r & 1); p0_transpose_item(INF(I_WX) + blk * 4096, 64, WLRU + 32768 + blk * 4096, 64, 0, n0, n0, scr, lane); }
        }
        for (int i = blockIdx.x * (NWAVES * 64) + tid; i < TSEQ * 8; i += F.G * NWAVES * 64) { const int pos = i >> 3, k = i & 7; const float ang = (float)pos * args.inv_freq[k];
            const double ad = (double)ang, nn = rint(ad * 0.15915494309189535); const float rf = (float)(ad - nn * 6.283185307179586);
            ROPE[(size_t)pos * 16 + k] = cosf(rf); ROPE[(size_t)pos * 16 + 8 + k] = sinf(rf); }
        { f32x4 g[4]; row_load(INF(I_NPM), lane, g);
          for (int m = gw; m < MTOT; m += NGW) { const float* xr = m < MP ? INF(I_XP) + (size_t)m * DM : INF(I_XS) + (size_t)(m - MP) * DM; f32x4 v[4]; row_load(xr, lane, v);
              const float rstd = 1.f / sqrtf(row_ssq(v) * (1.f / DM) + 1e-6f);
#pragma unroll
              for (int j = 0; j < 4; ++j) v[j] = v[j] * rstd * g[j];
              row_store_bf16(XN + (size_t)m * DM, lane, v); } }
        for (int m = gw; m < MTOT; m += NGW) { const float* pr = m < MP ? INF(I_PP) + (size_t)m * PLE : INF(I_PS) + (size_t)(m - MP) * PLE; const f32x4 v = ((const GAS f32x4*)pr)[lane];
            ((GAS unsigned long long*)(PB + (size_t)m * PLE))[lane] = (unsigned long long)pk2(v.x, v.y) | ((unsigned long long)pk2(v.z, v.w) << 32); }
        }
        if (BOTH(0)) GRID_BAR();
    }

    if (IN(1)) {
        const int lane = lane_now(), tid = F.wave * 64 + lane; (void)tid;
        { pg8::Gemm g{XN, WIN, MP, INW, DM}; pg8::StaticOrder S; S.init(MP, INW, F.G, (int)blockIdx.x);
          EpiIn E{XL, GG, QB_, KB_, VB_, args.out + OK_P, args.out + OV_P, ROPE};
          pg8::gemm_phase<EpiIn, pg8::StaticOrder, true, true>(F.lds + RING_OFF, g, S, E); }
        { const int half = F.G / 2;
          if ((int)blockIdx.x >= half) { pg8::Gemm g{PB, WPP, MP, DM, PLE}; pg8::StaticOrder S; S.init(MP, DM, F.G - half, (int)blockIdx.x - half);
              EpiBf E{PROJ, DM};
              pg8::gemm_phase<EpiBf, pg8::StaticOrder, true, true>(F.lds + RING_OFF, g, S, E); } }
        __syncthreads();
        small_gemm<0>(F, XN + (size_t)MP * DM, DM, WIN, INW, DM, US, INW);
        small_gemm<0>(F, PB + (size_t)MP * PLE, PLE, WPP, DM, PLE, PJS, DM);
        if (BOTH(1)) GRID_BAR();
    }

    if (IN(2)) {
        const int lane = lane_now(), tid = F.wave * 64 + lane; (void)tid;
        LruArgs LA{XL, INF(I_CONVW), INF(I_CONVB), WLRU, INF(I_BA), INF(I_BX), INF(I_L), HL, PC, CHS, US, INF(I_SCONV), INF(I_SH), args.out + OH_S, AMIX};
        for (int rep_ = 0; rep_ < REP_LRU; ++rep_) {
        for (int c = (int)blockIdx.x; c < NCHUNK; c += F.G) lru_unit<false>(F, LA, c);
        for (int c = F.G - 1 - (int)blockIdx.x; c < MS / 16; c += F.G) lru_unit<true>(F, LA, c);
        }
        for (int i = blockIdx.x * (NWAVES * 64) + tid; i < MS * 3 * LW; i += F.G * NWAVES * 64) { const int b = i / (3 * LW), r = (i / LW) % 3, ch = i % LW;
            args.out[OC_S + i] = r < 2 ? INF(I_SCONV)[((size_t)b * 3 + r + 1) * LW + ch] : US[(size_t)b * INW + ch]; }
        for (int i = blockIdx.x * (NWAVES * 64) + tid; i < NBATCH * 3 * LW; i += F.G * NWAVES * 64) { const int b = i / (3 * LW), r = (i / LW) % 3, ch = i % LW;
            args.out[OC_P + i] = XL[((size_t)b * TSEQ + TSEQ - 3 + r) * LW + ch]; }
        __syncthreads();
        {
            DecArgs DA{US, ROPE, INF(I_CK), INF(I_CV), (const int*)args.in[I_PT], args.out + OK_S, args.out + OV_S, QS, DP};
            const bool dec_first = (((int)blockIdx.x >> 3) & 3) == 0;
            const int myx = (int)(xb_xcc_id() & 7u);
            volatile LAS int* qslot = (volatile LAS int*)(F.MISC + 16);
#define Q_PULL(ctr, var) do { if (F.wave == 0 && lane_now() == 0) *qslot = (int)__hip_atomic_fetch_add((ctr), 1u, __ATOMIC_RELAXED, __HIP_MEMORY_SCOPE_AGENT); __syncthreads(); var = __builtin_amdgcn_readfirstlane(*qslot); __syncthreads(); } while (0)
            if (dec_first) for (;;) { int u; Q_PULL((unsigned*)(F.ctl + CW_QDEC), u); if (u >= MS * 2) break; decode_unit(F, DA, u >> 1, u & 1); }
            for (int kx = 0; kx < 8; ++kx) { const int x = (myx + kx) & 7;
                for (;;) { int iu; Q_PULL((unsigned*)(F.ctl + CW_QATT + 64 * x), iu); if (iu >= 128) break;
                    const int qb = 31 - (iu >> 2), bh = 4 * x + (iu & 3), b = bh >> 4, vh = bh & 15, hh = vh >> 2, mi = (vh >> 1) & 1, vj = vh & 1;
                    attn_body::attn_unit<8>(b, hh * 128 + mi * 64, hh * 128 + mi * 64, hh * 128 + vj * 64, mi * 512 + hh * 128 + vj * 64, qb,
                                            (const attn_body::bf16*)QB_, (const attn_body::bf16*)KB_, (const attn_body::bf16*)VB_, (attn_body::bf16*)OB, (char*)lds + RING_OFF); } }
            if (!dec_first) for (;;) { int u; Q_PULL((unsigned*)(F.ctl + CW_QDEC), u); if (u >= MS * 2) break; decode_unit(F, DA, u >> 1, u & 1); }
#undef Q_PULL
        }
        if (BOTH(2)) GRID_BAR();
    }

    if (IN(3)) {
        const int lane = lane_now(), tid = F.wave * 64 + lane; (void)tid;
        for (int rep_ = 0; rep_ < REP_P3; ++rep_) {
        const float lam = expf(wave_sum(INF(I_LQ1)[lane] * INF(I_LK1)[lane])) - expf(wave_sum(INF(I_LQ2)[lane] * INF(I_LK2)[lane])) + LAM_INIT;
        for (int c = (int)blockIdx.x; c < NCHUNK; c += F.G) {
            const int cb = c & ~(TSEQ / CHUNK - 1), nprev = c - cb, seg = (nprev + 7) >> 3;
            LAS float* SA = (LAS float*)(F.lds + RING_OFF); LAS float* SB = SA + 8 * LW; LAS float* CR = SB + 8 * LW;
            {
              float ca[8], cbv[8];
#pragma unroll
              for (int e = 0; e < 8; ++e) { ca[e] = 1.f; cbv[e] = 0.f; }
              const int c_lo = cb + F.wave * seg, c_hi = (c_lo + seg < c) ? c_lo + seg : c;
              for (int cc = c_lo; cc < c_hi; ++cc) { const float* pp = CHS + (size_t)cc * 2 * LW + 8 * lane; const f32x4 p0 = *(const f32x4*)pp, p1 = *(const f32x4*)(pp + 4), h0 = *(const f32x4*)(pp + LW), h1 = *(const f32x4*)(pp + LW + 4);
#pragma unroll
                  for (int e = 0; e < 4; ++e) { ca[e] *= p0[e]; cbv[e] = cbv[e] * p0[e] + h0[e]; ca[4 + e] *= p1[e]; cbv[4 + e] = cbv[4 + e] * p1[e] + h1[e]; } }
#pragma unroll
              for (int e = 0; e < 8; ++e) { SA[F.wave * LW + 8 * lane + e] = ca[e]; SB[F.wave * LW + 8 * lane + e] = cbv[e]; } }
            __syncthreads();
            { float carry = 0.f;
#pragma unroll
              for (int w2 = 0; w2 < 8; ++w2) carry = SA[w2 * LW + tid] * carry + SB[w2 * LW + tid];
              CR[tid] = carry;
              if ((c & (TSEQ / CHUNK - 1)) == TSEQ / CHUNK - 1) args.out[OH_P + (size_t)(c / (TSEQ / CHUNK)) * LW + tid] = CHS[(size_t)c * 2 * LW + tid] * carry + CHS[(size_t)c * 2 * LW + LW + tid]; }
            __syncthreads();
#pragma unroll 2
            for (int k8 = 0; k8 < 8; ++k8) { const int idx = tid + 512 * k8, r = idx >> 6, g8 = (idx & 63) * 8; const size_t o = (size_t)(c * CHUNK + r) * LW + g8;
                const f32x4 h0 = *(const f32x4*)(HL + o), h1 = *(const f32x4*)(HL + o + 4), p0 = *(const f32x4*)(PC + o), p1 = *(const f32x4*)(PC + o + 4); const v4u gw_ = *(const v4u*)(GG + o);
                const f32x4 c0 = *(const LAS f32x4*)(CR + g8), c1 = *(const LAS f32x4*)(CR + g8 + 4);
                const unsigned ga[4] = {gw_.x, gw_.y, gw_.z, gw_.w}; float y[8];
#pragma unroll
                for (int e = 0; e < 4; ++e) { y[e] = h0[e] + p0[e] * c0[e]; y[4 + e] = h1[e] + p1[e] * c1[e]; }
#pragma unroll
                for (int e = 0; e < 4; ++e) { y[2 * e] *= bf2f((unsigned short)(ga[e] & 0xffff)); y[2 * e + 1] *= bf2f((unsigned short)(ga[e] >> 16)); }
                v4u w; w.x = pk2(y[0], y[1]); w.y = pk2(y[2], y[3]); w.z = pk2(y[4], y[5]); w.w = pk2(y[6], y[7]);
                *(v4u*)(AMIX + (size_t)(c * CHUNK + r) * DM + g8) = w; }
            __syncthreads();
            for (int rr = 0; rr < 8; ++rr) { const int row = c * CHUNK + F.wave * 8 + rr;
                const v4u w1 = *(const v4u*)(OB + (size_t)row * 1024 + 8 * lane), w2 = *(const v4u*)(OB + (size_t)row * 1024 + 512 + 8 * lane);
                float o[8]; const unsigned a1[4] = {w1.x, w1.y, w1.z, w1.w}, a2[4] = {w2.x, w2.y, w2.z, w2.w};
#pragma unroll
                for (int e = 0; e < 4; ++e) { o[2 * e] = bf2f((unsigned short)(a1[e] & 0xffff)) - lam * bf2f((unsigned short)(a2[e] & 0xffff)); o[2 * e + 1] = bf2f((unsigned short)(a1[e] >> 16)) - lam * bf2f((unsigned short)(a2[e] >> 16)); }
                float ss = 0.f;
#pragma unroll
                for (int e = 0; e < 8; ++e) ss += o[e] * o[e];
                ss = row16_sum(ss);
                const float rstd = SUBLN_SCALE / sqrtf(ss * (1.f / 128.f) + 1e-5f);
                const float* gp = INF(I_SUBG) + 8 * (lane & 15); const f32x4 g0 = *(const f32x4*)gp, g1 = *(const f32x4*)(gp + 4);
                v4u w; w.x = pk2(o[0] * rstd * g0[0], o[1] * rstd * g0[1]); w.y = pk2(o[2] * rstd * g0[2], o[3] * rstd * g0[3]); w.z = pk2(o[4] * rstd * g1[0], o[5] * rstd * g1[1]); w.w = pk2(o[6] * rstd * g1[2], o[7] * rstd * g1[3]);
                *(v4u*)(AMIX + (size_t)row * DM + 512 + 8 * lane) = w; }
        }
        for (int it = gw; it < MS * 4; it += NGW) { const int b = it >> 2, head = it & 3;
            const float* q = QS + (size_t)b * AW + head * 128; const float* kn = args.out + OK_S + (size_t)b * AW + head * 128; const float* vn = args.out + OV_S + (size_t)b * AW + head * 128;
            const float s1n = wave_sum(q[lane] * kn[lane]), s2n = wave_sum(q[64 + lane] * kn[64 + lane]);
            const float* d0 = DP + ((size_t)(b * 2 + 0) * 4 + head) * DP_STRIDE; const float* d1 = DP + ((size_t)(b * 2 + 1) * 4 + head) * DP_STRIDE;
            float om[2][2];
#pragma unroll
            for (int mp = 0; mp < 2; ++mp) { const float* e0 = d0 + mp * 132; const float* e1 = d1 + mp * 132; const float sn = mp ? s2n : s1n;
                const float M = fmaxf(fmaxf(e0[128], e1[128]), sn); const float wa = __builtin_amdgcn_exp2f(e0[128] - M), wb = __builtin_amdgcn_exp2f(e1[128] - M), wn = __builtin_amdgcn_exp2f(sn - M);
                const float L = e0[129] * wa + e1[129] * wb + wn, il = 1.f / L;
                om[mp][0] = (e0[2 * lane] * wa + e1[2 * lane] * wb + vn[2 * lane] * wn) * il; om[mp][1] = (e0[2 * lane + 1] * wa + e1[2 * lane + 1] * wb + vn[2 * lane + 1] * wn) * il; }
            const float o0 = om[0][0] - lam * om[1][0], o1 = om[0][1] - lam * om[1][1];
            const float rstd = SUBLN_SCALE / sqrtf(wave_sum(o0 * o0 + o1 * o1) * (1.f / 128.f) + 1e-5f);
            *(unsigned*)(AMIX + (size_t)(MP + b) * DM + 512 + head * 128 + 2 * lane) = pk2(o0 * rstd * INF(I_SUBG)[2 * lane], o1 * rstd * INF(I_SUBG)[2 * lane + 1]); }
        }
        if (BOTH(3)) GRID_BAR();
    }

    if (IN(4)) {
        const int lane = lane_now(), tid = F.wave * 64 + lane; (void)tid;
        { pg8::Gemm g{AMIX, WOUT, MP, DM, DM}; pg8::StaticOrder S; S.init(MP, DM, F.G, (int)blockIdx.x); EpiF32 E{MIX, DM};
          pg8::gemm_phase<EpiF32, pg8::StaticOrder, true, true>(F.lds + RING_OFF, g, S, E); }
        __syncthreads();
        small_gemm<0>(F, AMIX + (size_t)MP * DM, DM, WOUT, DM, DM, MIX + (size_t)MP * DM, DM);
        if (BOTH(4)) GRID_BAR();
    }

    if (IN(5)) {
        const int lane = lane_now(), tid = F.wave * 64 + lane; (void)tid;
        for (int rep_ = 0; rep_ < REP_P5; ++rep_) {
        f32x4 g1[4], g2[4]; row_load(INF(I_NPOSTM), lane, g1); row_load(INF(I_NPREF), lane, g2);
        for (int m = gw; m < MTOT; m += NGW) { const float* xr = m < MP ? INF(I_XP) + (size_t)m * DM : INF(I_XS) + (size_t)(m - MP) * DM; f32x4 x[4], v[4]; row_load(xr, lane, x); row_load(MIX + (size_t)m * DM, lane, v);
            const float rstd = 1.f / sqrtf(row_ssq(v) * (1.f / DM) + 1e-6f);
#pragma unroll
            for (int j = 0; j < 4; ++j) x[j] = x[j] + v[j] * rstd * g1[j];
            row_store_f32(X1 + (size_t)m * DM, lane, x);
            const float rstd2 = 1.f / sqrtf(row_ssq(x) * (1.f / DM) + 1e-6f);
#pragma unroll
            for (int j = 0; j < 4; ++j) v[j] = x[j] * rstd2 * g2[j];
            row_store_bf16(XN + (size_t)m * DM, lane, v); }
        }
        if (BOTH(5)) GRID_BAR();
    }

    if (IN(6)) {
        const int lane = lane_now(), tid = F.wave * 64 + lane; (void)tid;
        { pg8::Gemm g{XN, WGU, MP, GU, DM}; pg8::StaticOrder S; S.init(MP, GU, F.G, (int)blockIdx.x); EpiSwiGlu E{HB};
          pg8::gemm_phase<EpiSwiGlu, pg8::StaticOrder, true, true>(F.lds + RING_OFF, g, S, E); }
        __syncthreads();
        small_gemm<0>(F, XN + (size_t)MP * DM, DM, WGU, GU, DM, GUS, GU);
        if (BOTH(6)) GRID_BAR();
    }

    if (IN(7)) {
        const int lane = lane_now(), tid = F.wave * 64 + lane; (void)tid;
        { pg8::Gemm g{HB, WD, MP, DM, FF}; pg8::StaticOrder S; S.init(MP, DM, F.G, (int)blockIdx.x); EpiF32 E{MIX, DM};
          pg8::gemm_phase<EpiF32, pg8::StaticOrder, true, true>(F.lds + RING_OFF, g, S, E); }
        __syncthreads();
        small_gemm<2>(F, GUS, GU, WD, DM, FF, MIX + (size_t)MP * DM, DM);
        if (BOTH(7)) GRID_BAR();
    }

    if (IN(8)) {
        const int lane = lane_now(), tid = F.wave * 64 + lane; (void)tid;
        f32x4 g1[4]; row_load(INF(I_NPOSTF), lane, g1);
        for (int m = gw; m < MTOT; m += NGW) { f32x4 x[4], v[4]; row_load(X1 + (size_t)m * DM, lane, x); row_load(MIX + (size_t)m * DM, lane, v);
            const float rstd = 1.f / sqrtf(row_ssq(v) * (1.f / DM) + 1e-6f);
#pragma unroll
            for (int j = 0; j < 4; ++j) x[j] = x[j] + v[j] * rstd * g1[j];
            row_store_f32(X1 + (size_t)m * DM, lane, x); row_store_bf16(XN + (size_t)m * DM, lane, x); }
        if (BOTH(8)) GRID_BAR();
    }

    if (IN(9)) {
        const int lane = lane_now(), tid = F.wave * 64 + lane; (void)tid;
        { pg8::Gemm g{XN, WPG, MP, DM, DM}; pg8::StaticOrder S; S.init(MP, DM, F.G, (int)blockIdx.x); EpiPle E{PROJ, MIX};
          pg8::gemm_phase<EpiPle, pg8::StaticOrder, true, true>(F.lds + RING_OFF, g, S, E); }
        __syncthreads();
        small_gemm<0>(F, XN + (size_t)MP * DM, DM, WPG, DM, DM, GS, DM);
        if (BOTH(9)) GRID_BAR();
    }

    if (IN(10)) {
        const int lane = lane_now(), tid = F.wave * 64 + lane; (void)tid;
        for (int rep_ = 0; rep_ < REP_P10; ++rep_) {
        f32x4 g1[4]; row_load(INF(I_PNORM), lane, g1);
        for (int m = gw; m < MTOT; m += NGW) { f32x4 x[4], v[4]; row_load(X1 + (size_t)m * DM, lane, x);
            if (m < MP) row_load(MIX + (size_t)m * DM, lane, v);
            else { f32x4 a[4], b[4]; row_load(GS + (size_t)(m - MP) * DM, lane, a); row_load(PJS + (size_t)(m - MP) * DM, lane, b);
#pragma unroll
                for (int j = 0; j < 4; ++j) { v[j].x = sigmoidf_(a[j].x) * b[j].x; v[j].y = sigmoidf_(a[j].y) * b[j].y; v[j].z = sigmoidf_(a[j].z) * b[j].z; v[j].w = sigmoidf_(a[j].w) * b[j].w; } }
            const float rstd = 1.f / sqrtf(row_ssq(v) * (1.f / DM) + 1e-6f);
#pragma unroll
            for (int j = 0; j < 4; ++j) x[j] = x[j] + v[j] * rstd * g1[j];
            row_store_f32(m < MP ? args.out + OY_P + (size_t)m * DM : args.out + OY_S + (size_t)(m - MP) * DM, lane, x); }
        }
    }
#undef IN
#undef BOTH
#undef INF
}

extern "C" void kernel_launch(void* const* d_in, const int* in_sizes, int n_in, void* d_out, int out_size, void* d_ws, size_t ws_size, hipStream_t stream) {
    static int grid = 0;
    if (grid == 0) {
        if (n_in != 33 || (size_t)out_size != OUT_TOTAL || ws_size < WS_END) { fprintf(stderr, "kernel_launch: unexpected sizes (n_in %d, out %d, ws %zu, need %zu)\n", n_in, out_size, ws_size, (size_t)WS_END); grid = -1; return; }
        int dev = 0, cus = 0, per_cu = 0;
        if (hipGetDevice(&dev) != hipSuccess || hipDeviceGetAttribute(&cus, hipDeviceAttributeMultiprocessorCount, dev) != hipSuccess) { grid = -1; return; }
        if (hipFuncSetAttribute((const void*)hymba_fwd, hipFuncAttributeMaxDynamicSharedMemorySize, LDS_BYTES) != hipSuccess) { fprintf(stderr, "kernel_launch: hipFuncSetAttribute failed\n"); grid = -1; return; }
        if (hipOccupancyMaxActiveBlocksPerMultiprocessor(&per_cu, (const void*)hymba_fwd, NWAVES * 64, LDS_BYTES) != hipSuccess || per_cu < 1) { fprintf(stderr, "kernel_launch: occupancy query says %d\n", per_cu); }
        (void)hipGetLastError();
        grid = cus;
    }
    if (grid < 0) return;
    (void)hipMemsetAsync((char*)d_ws + WS_CTL, 0, CTL_ZERO_BYTES, stream);
    Args a{};
    for (int i = 0; i < 33; ++i) a.in[i] = d_in[i];
    a.out = (float*)d_out; a.ws = (unsigned char*)d_ws;
    for (int i = 0; i < 8; ++i) a.inv_freq[i] = (float)pow(500000.0, -(double)i / 8.0);
    constexpr int NL = MK_N_LAUNCHES;
    for (int li = 0; li < NL; ++li) {
        a.ph_lo = (NL == 1) ? 0 : li; a.ph_hi = (NL == 1) ? N_PHASES : li + 1; a.li = (NL == 1) ? 0 : 0; a.pad = 0;
        hipLaunchKernelGGL(hymba_fwd, dim3(grid), dim3(NWAVES * 64), LDS_BYTES, stream, a);
    }
}
```
